# Optimizing an MI355X kernel written in HIP

```python
import jax, jax.numpy as jnp
from jax import lax
import numpy as np

D_MODEL = 2048
BATCH = 4
SEQ = 2048
DEPTH = 2
DEC_BATCH = 8
DEC_SEQ = 32
PAST_LEN = 1024

CHUNK = 64
N_MIXERS = 2
N_A_LAYERS = (DEPTH + 1) // 2
N_B_LAYERS = DEPTH // 2
EXPAND = 2
GM_WIDTH = EXPAND * D_MODEL
GM_BLOCK = 128
GM_GROUPS = 16
GM_GROUP_DIM = GM_WIDTH // GM_GROUPS
SB_HEADS = 16
SB_HEAD_DIM = D_MODEL // SB_HEADS
SB_WIDTH = SB_HEADS * SB_HEAD_DIM
SB_Q_BLOCK = 128
NORM_EPS = 1e-6
LN_EPS = 1e-5

kernel_name = "stickbreak_gmlp_hybrid_stream_step"


def rms_norm(x, g):
    xf = x.astype(jnp.float32)
    y = xf * lax.rsqrt(jnp.mean(xf * xf, axis=-1, keepdims=True) + NORM_EPS)
    return (y * g.astype(jnp.float32)).astype(x.dtype)


def layer_norm(x, g, b):
    xf = x.astype(jnp.float32)
    mu = jnp.mean(xf, axis=-1, keepdims=True)
    xc = xf - mu
    var = jnp.mean(xc * xc, axis=-1, keepdims=True)
    y = xc * lax.rsqrt(var + LN_EPS) * g.astype(jnp.float32) + b.astype(jnp.float32)
    return y.astype(x.dtype)


def chunk_causal_mask(n):
    pos = jnp.arange(n)
    return (pos[None, :] // CHUNK) <= (pos[:, None] // CHUNK)


def gmlp_branch(h, w_in, ln_g, ln_b, w_s, b_s, w_out):
    bsz, seq_len, _ = h.shape
    blk = min(seq_len, GM_BLOCK)
    n_blk = seq_len // blk
    proj = jnp.einsum('bld,de->ble', h, w_in)
    u, v, z = jnp.split(proj, 3, axis=-1)
    u = jax.nn.gelu(u)
    v = layer_norm(jax.nn.gelu(v), ln_g, ln_b)
    w = w_s[:, :blk, :blk] * chunk_causal_mask(blk).astype(w_s.dtype)
    vb = v.reshape(bsz, n_blk, blk, GM_GROUPS, GM_GROUP_DIM)
    mixed = jnp.einsum('gts,bnsgc->bntgc', w, vb) + b_s[:, :blk].T[None, None, :, :, None]
    s = u * mixed.reshape(bsz, seq_len, GM_WIDTH)
    y = s * jax.nn.silu(z)
    return jnp.einsum('ble,ed->bld', y, w_out), v


def stick_breaking_attend(q, k, v, q_offset):
    tq = q.shape[1]
    scale = SB_HEAD_DIM ** -0.5
    outs = []
    for start in range(0, tq, SB_Q_BLOCK):
        stop = min(start + SB_Q_BLOCK, tq)
        n_keys = q_offset + stop
        qb = q[:, start:stop].astype(jnp.float32)
        kb = k[:, :n_keys].astype(jnp.float32)
        vb = v[:, :n_keys].astype(jnp.float32)
        logits = jnp.einsum('bqhd,bkhd->bhqk', qb, kb) * scale
        t_pos = q_offset + jnp.arange(start, stop)
        s_pos = jnp.arange(n_keys)
        strict = s_pos[None, :] < t_pos[:, None]
        log_fail = jnp.where(strict, jax.nn.log_sigmoid(-logits), 0.0)
        later_fail = lax.cumsum(log_fail, axis=3, reverse=True) - log_fail
        weights = jnp.where(strict, jnp.exp(jax.nn.log_sigmoid(logits) + later_fail), 0.0)
        outs.append(jnp.einsum('bhqk,bkhd->bqhd', weights, vb))
    return jnp.concatenate(outs, axis=1).astype(v.dtype)


def sb_branch(h, w_in, w_out, cache_k, cache_v):
    bsz, seq_len, _ = h.shape
    proj = jnp.einsum('bld,de->ble', h, w_in)
    q, k, v, z = jnp.split(proj, 4, axis=-1)
    q = q.reshape(bsz, seq_len, SB_HEADS, SB_HEAD_DIM)
    k = k.reshape(bsz, seq_len, SB_HEADS, SB_HEAD_DIM)
    v = v.reshape(bsz, seq_len, SB_HEADS, SB_HEAD_DIM)
    if cache_k is None:
        o = stick_breaking_attend(q, k, v, 0)
    else:
        k_all = jnp.concatenate([cache_k.astype(k.dtype), k], axis=1)
        v_all = jnp.concatenate([cache_v.astype(v.dtype), v], axis=1)
        o = stick_breaking_attend(q, k_all, v_all, cache_k.shape[1])
    y = o.reshape(bsz, seq_len, SB_WIDTH) * jax.nn.silu(z)
    return jnp.einsum('ble,ed->bld', y, w_out), k, v


def setup_inputs(seed: int = 0) -> dict:
    key = jax.random.key(seed)
    ks = jax.random.split(key, 16)
    f32 = jnp.float32
    x_prompt = jax.random.normal(ks[0], (BATCH, SEQ, D_MODEL), f32)
    x_sample = jax.random.normal(ks[1], (DEC_BATCH, DEC_SEQ, D_MODEL), f32)
    cache_sb_k = jax.random.normal(ks[2], (N_B_LAYERS, DEC_BATCH, PAST_LEN, SB_HEADS, SB_HEAD_DIM), f32)
    cache_sb_v = jax.random.normal(ks[3], (N_B_LAYERS, DEC_BATCH, PAST_LEN, SB_HEADS, SB_HEAD_DIM), f32)
    norm_g = 1.0 + 0.02 * jax.random.normal(ks[4], (DEPTH, D_MODEL), f32)
    final_norm_g = 1.0 + 0.02 * jax.random.normal(ks[5], (D_MODEL,), f32)
    gm_w_in = jax.random.normal(ks[6], (N_A_LAYERS, D_MODEL, 3 * GM_WIDTH), f32) * D_MODEL ** -0.5
    gm_ln_g = 1.0 + 0.02 * jax.random.normal(ks[7], (N_A_LAYERS, GM_WIDTH), f32)
    gm_ln_b = 0.02 * jax.random.normal(ks[8], (N_A_LAYERS, GM_WIDTH), f32)
    gm_w_s = jax.random.normal(ks[9], (N_A_LAYERS, GM_GROUPS, GM_BLOCK, GM_BLOCK), f32) * GM_BLOCK ** -0.5
    gm_b_s = 1.0 + 0.02 * jax.random.normal(ks[10], (N_A_LAYERS, GM_GROUPS, GM_BLOCK), f32)
    gm_w_out = jax.random.normal(ks[11], (N_A_LAYERS, GM_WIDTH, D_MODEL), f32) * GM_WIDTH ** -0.5
    sb_w_in = jax.random.normal(ks[12], (N_B_LAYERS, D_MODEL, 4 * SB_WIDTH), f32) * D_MODEL ** -0.5
    sb_w_out = jax.random.normal(ks[13], (N_B_LAYERS, SB_WIDTH, D_MODEL), f32) * SB_WIDTH ** -0.5
    return {"x_prompt": x_prompt, "x_sample": x_sample, "cache_sb_k": cache_sb_k, "cache_sb_v": cache_sb_v,
            "norm_g": norm_g, "final_norm_g": final_norm_g,
            "gm_w_in": gm_w_in, "gm_ln_g": gm_ln_g, "gm_ln_b": gm_ln_b, "gm_w_s": gm_w_s, "gm_b_s": gm_b_s,
            "gm_w_out": gm_w_out, "sb_w_in": sb_w_in, "sb_w_out": sb_w_out}


def reference(x_prompt, x_sample, cache_sb_k, cache_sb_v, norm_g, final_norm_g,
              gm_w_in, gm_ln_g, gm_ln_b, gm_w_s, gm_b_s, gm_w_out, sb_w_in, sb_w_out):
    xp, xs = x_prompt, x_sample
    gm_v_rows = []
    kp_rows, vp_rows, ks_rows, vs_rows = [], [], [], []
    for i in range(DEPTH):
        hp = rms_norm(xp, norm_g[i])
        hs = rms_norm(xs, norm_g[i])
        j = i // N_MIXERS
        if i % N_MIXERS == 0:
            dp, _ = gmlp_branch(hp, gm_w_in[j], gm_ln_g[j], gm_ln_b[j], gm_w_s[j], gm_b_s[j], gm_w_out[j])
            ds, v_new = gmlp_branch(hs, gm_w_in[j], gm_ln_g[j], gm_ln_b[j], gm_w_s[j], gm_b_s[j], gm_w_out[j])
            gm_v_rows.append(v_new)
        else:
            dp, kp, vp = sb_branch(hp, sb_w_in[j], sb_w_out[j], None, None)
            ds, kn, vn = sb_branch(hs, sb_w_in[j], sb_w_out[j], cache_sb_k[j], cache_sb_v[j])
            kp_rows.append(kp)
            vp_rows.append(vp)
            ks_rows.append(kn)
            vs_rows.append(vn)
        xp = xp + dp
        xs = xs + ds
    y_prompt = rms_norm(xp, final_norm_g)
    y_sample = rms_norm(xs, final_norm_g)
    k_prompt_new = jnp.stack(kp_rows)
    v_prompt_new = jnp.stack(vp_rows)
    k_sample_new = jnp.stack(ks_rows)
    v_sample_new = jnp.stack(vs_rows)
    gm_v_sample = jnp.stack(gm_v_rows)
    return (y_prompt, y_sample, k_prompt_new, v_prompt_new, k_sample_new, v_sample_new, gm_v_sample)
```

```cpp
#include <hip/hip_runtime.h>
#include <hip/hip_cooperative_groups.h>
#include <cstdio>
#include <cstdint>
namespace cg = cooperative_groups;

#define LAS __attribute__((address_space(3)))
typedef unsigned short bf16_t;
typedef short bf16x8 __attribute__((ext_vector_type(8)));
typedef short s16x4 __attribute__((ext_vector_type(4)));
typedef float f32x4 __attribute__((ext_vector_type(4)));
typedef float f32x2 __attribute__((ext_vector_type(2)));
typedef unsigned u32x4 __attribute__((ext_vector_type(4)));
typedef unsigned u32x2 __attribute__((ext_vector_type(2)));

constexpr int DM = 2048, MP = 8192, MS = 256, MT = MP + MS;
constexpr int GW = 4096, N1 = 3 * GW, N3 = 4 * DM;
constexpr size_t MiB = 1u << 20;
constexpr size_t WS_CTL = 0;
constexpr size_t WS_W1T = 4 * MiB, WS_W2T = 52 * MiB, WS_W3T = 68 * MiB, WS_W4T = 100 * MiB;
constexpr size_t WS_RA = 108 * MiB;
constexpr size_t WS_RB = 141 * MiB;
constexpr size_t WS_LNP = 339 * MiB;
constexpr size_t WS_SS1 = 344 * MiB;
constexpr size_t WS_SS2 = 346 * MiB;
constexpr size_t SZ_G = (size_t)MT * GW;
constexpr size_t SZ_D = (size_t)MT * DM;
constexpr size_t O_YP = 0, O_YS = (size_t)MP * DM, O_KP = O_YS + (size_t)MS * DM, O_VP = O_KP + (size_t)MP * DM, O_KS = O_VP + (size_t)MP * DM, O_VS = O_KS + (size_t)MS * DM, O_GMV = O_VS + (size_t)MS * DM;

struct Params {
    const float* xp; const float* xs; const float* ck; const float* cv; const float* norm_g; const float* fng;
    const float* w1; const float* lng; const float* lnb; const float* wsp; const float* bsp; const float* w2; const float* w3; const float* w4;
    float* out; unsigned char* ws;
};

__device__ __forceinline__ unsigned cvt_pk_bf16(float lo, float hi) { unsigned r; asm volatile("v_cvt_pk_bf16_f32 %0, %1, %2" : "=v"(r) : "v"(lo), "v"(hi)); return r; }
__device__ __forceinline__ void st_wt16(void* ptr, u32x4 v) { asm volatile("global_store_dwordx4 %0, %1, off sc1\n\ts_nop 1" :: "v"(ptr), "v"(v) : "memory"); }
__device__ __forceinline__ void st_wt8(void* ptr, u32x2 v) { asm volatile("global_store_dwordx2 %0, %1, off sc1" :: "v"(ptr), "v"(v) : "memory"); }
__device__ __forceinline__ void st_wt4(void* ptr, unsigned v) { asm volatile("global_store_dword %0, %1, off sc1" :: "v"(ptr), "v"(v) : "memory"); }
__device__ __forceinline__ float bf_lo(unsigned w) { return __uint_as_float(w << 16); }
__device__ __forceinline__ float bf_hi(unsigned w) { return __uint_as_float(w & 0xffff0000u); }
__device__ __forceinline__ float fast_sigmoid_mul(float x, float arg) { return x * __builtin_amdgcn_rcpf(1.0f + __builtin_amdgcn_exp2f(-1.4426950408889634f * arg)); }
__device__ __forceinline__ float gelu_tanh(float x) { return fast_sigmoid_mul(x, x * (1.5957691216057308f + 0.07135481627260025f * x * x)); }
__device__ __forceinline__ float silu(float x) { return fast_sigmoid_mul(x, x); }
__device__ __forceinline__ f32x2 exp2_2(f32x2 a) { f32x2 r; r.x = __builtin_amdgcn_exp2f(a.x); r.y = __builtin_amdgcn_exp2f(a.y); return r; }
__device__ __forceinline__ f32x2 rcp_2(f32x2 a) { f32x2 r; r.x = __builtin_amdgcn_rcpf(a.x); r.y = __builtin_amdgcn_rcpf(a.y); return r; }
__device__ __forceinline__ f32x2 gelu_den2(f32x2 x) { return exp2_2(x * ((x * x) * (-0.10294324f) + (-2.3022082f))) + 1.0f; }
__device__ __forceinline__ f32x2 silu_den2(f32x2 x) { return exp2_2(x * (-1.4426950408889634f)) + 1.0f; }
__device__ __forceinline__ f32x2 gelu2(f32x2 x) { return x * rcp_2(gelu_den2(x)); }
__device__ __forceinline__ f32x2 silu2(f32x2 x) { return x * rcp_2(silu_den2(x)); }
__device__ __forceinline__ f32x2 guz2(f32x2 u, f32x2 z) { return (u * z) * rcp_2(gelu_den2(u) * silu_den2(z)); }
__device__ __forceinline__ float wave_sum(float v) {
#pragma unroll
    for (int o = 1; o < 64; o <<= 1) v += __shfl_xor(v, o);
    return v;
}

namespace pg8 {
constexpr int BM = 256, BK = 64, HALF = 128, HTB = HALF * BK * 2, STAGE_BYTES = 8 * HTB, NXCD = 8, WGM = 8;
__host__ __device__ __forceinline__ int lds_byte(int r, int c) { const int st = (r >> 4) * 2 + (c >> 5), rr = r & 15, cc = c & 31, ob = rr * 64 + cc * 2; return st * 1024 + (ob ^ (((ob >> 9) & 1) << 5)); }
__host__ __device__ __forceinline__ void stage_rc(int b, int& R, int& C) { const int st = b / 1024, sb = b % 1024, swz = sb ^ (((sb >> 9) & 1) << 5); R = (st >> 1) * 16 + swz / 64; C = (st & 1) * 32 + (swz % 64) / 2; }
__host__ __device__ __forceinline__ int perm32(int rho) { const int n = rho >> 4, i = rho & 15; return 8 * (i >> 2) + 4 * n + (i & 3); }
struct Unit { int pm, pn; };
struct Gemm { const bf16_t* A; const bf16_t* Bt; int M, N, K; };
struct StaticOrder {
    static constexpr bool PUBLISH = false; unsigned* cnt = nullptr;
    int nM, nN, nwg, G, c;
    __host__ __device__ void init(int M, int N, int G_, int c_) { nM = M / BM; nN = N / BM; nwg = nM * nN; G = G_; c = c_; }
    __host__ __device__ bool next(int i, Unit& u) const {
        const long L = (long)i * G + c; if (L >= nwg) return false;
        int wgid = (int)L; { const int q = nwg / NXCD, r = nwg % NXCD, xcd = wgid % NXCD, off = wgid / NXCD; wgid = (xcd < r ? xcd * (q + 1) : r * (q + 1) + (xcd - r) * q) + off; }
        const int nig = WGM * nN, gid = wgid / nig, fm = gid * WGM, gsz = (nM - fm) < WGM ? (nM - fm) : WGM;
        u.pm = fm + ((wgid % nig) % gsz); u.pn = (wgid % nig) / gsz; return true;
    }
    __device__ __forceinline__ void a_ready(const Unit&) const {}
    __device__ __forceinline__ void done(const Unit&) const {}
};
__device__ __forceinline__ void panel_publish(unsigned* cnt, int pm) {
    asm volatile("s_waitcnt vmcnt(0)" ::: "memory");
    __builtin_amdgcn_s_barrier();
    if (threadIdx.x < 64) {
        __builtin_amdgcn_fence(__ATOMIC_RELEASE, "agent");
        asm volatile("s_waitcnt vmcnt(0)" ::: "memory");
        if (threadIdx.x == 0) __hip_atomic_fetch_add(cnt + 64 * pm, 1u, __ATOMIC_RELAXED, __HIP_MEMORY_SCOPE_AGENT);
    }
}
__device__ __forceinline__ void panel_publish_wt(unsigned* cnt, int pm) {
    asm volatile("s_waitcnt vmcnt(0)" ::: "memory");
    __builtin_amdgcn_s_barrier();
    if (threadIdx.x == 0) __hip_atomic_fetch_add(cnt + 64 * pm, 1u, __ATOMIC_RELAXED, __HIP_MEMORY_SCOPE_AGENT);
}
__device__ __forceinline__ void panel_wait_wave0(unsigned* cnt, int pm, unsigned need) {
    unsigned polls = 0;
    while ((unsigned)__builtin_amdgcn_readfirstlane(__hip_atomic_load(cnt + 64 * pm, __ATOMIC_RELAXED, __HIP_MEMORY_SCOPE_AGENT)) < need) {
        __builtin_amdgcn_s_sleep(2);
        if (++polls > (1u << 22)) break;
    }
    __builtin_amdgcn_fence(__ATOMIC_ACQUIRE, "agent");
    asm volatile("s_waitcnt vmcnt(0)" ::: "memory");
}
struct OrderG1 {
    static constexpr bool PUBLISH = true;
    StaticOrder P; unsigned* cnt; int G, c;
    __device__ void init(int G_, int c_, unsigned* cnt_) { P.init(8192, 12288, G_, c_); G = G_; c = c_; cnt = cnt_; }
    __device__ bool next(int i, Unit& u) const { const int L = i * G + c; if (L < 1536) return P.next(i, u); if (L < 1584) { u.pm = 32; u.pn = L - 1536; return true; } return false; }
    __device__ __forceinline__ void a_ready(const Unit&) const {}
    __device__ __forceinline__ void done(const Unit& u) const { panel_publish_wt(cnt, u.pm); }
};
struct OrderG2 {
    static constexpr bool PUBLISH = true;
    StaticOrder P; unsigned* cnt; int G, c;
    __device__ void init(int G_, int c_, unsigned* cnt_) { P.init(8192, 2048, G_, c_); G = G_; c = c_; cnt = cnt_; }
    __device__ bool next(int i, Unit& u) const { const int L = i * G + c; if (L < 256) return P.next(i, u); if (L < 264) { u.pm = 32; u.pn = L - 256; return true; } return false; }
    __device__ __forceinline__ void a_ready(const Unit&) const {}
    __device__ __forceinline__ void done(const Unit& u) const { panel_publish_wt(cnt, u.pm); }
};
struct OrderG3 {
    static constexpr bool PUBLISH = false;
    StaticOrder P; unsigned* cnt; int G, c;
    __device__ void init(int G_, int c_, unsigned* cnt_) { P.init(8192, 8192, G_, c_); G = G_; c = c_; cnt = cnt_; }
    __device__ bool next(int i, Unit& u) const {
        if (G == 256) {
            if (i < 3) return P.next(i, u);
            if (i == 3) { if (c < 8) return false; return P.next(3, u); }
            if (i == 4) { if (c >= 8 && c < 16) { StaticOrder Q = P; Q.c = c - 8; return Q.next(3, u); } if (c >= 16 && c < 48) { u.pm = 32; u.pn = c - 16; return true; } }
            return false;
        }
        const int L = i * G + c; if (L < 1024) return P.next(i, u); if (L < 1056) { u.pm = 32; u.pn = L - 1024; return true; } return false;
    }
    __device__ __forceinline__ void a_ready(const Unit& u) const {
        if (threadIdx.x < 64) panel_wait_wave0(cnt, u.pm, 8u);
        asm volatile("" ::: "memory"); __builtin_amdgcn_s_barrier(); asm volatile("" ::: "memory");
    }
    __device__ __forceinline__ void done(const Unit&) const {}
};
struct OrderG4 {
    static constexpr bool PUBLISH = false;
    StaticOrder P; unsigned* cnt; int G, c;
    __device__ void init(int G_, int c_, unsigned* cnt_) { P.init(8192, 2048, G_, c_); G = G_; c = c_; cnt = cnt_; }
    __device__ bool next(int i, Unit& u) const {
        if (G == 256) { if (c < 8) { if (i == 0) { u.pm = 32; u.pn = c; return true; } return i == 1 ? P.next(0, u) : false; } return i == 0 ? P.next(0, u) : false; }
        const int L = i * G + c; if (L < 256) return P.next(i, u); if (L < 264) { u.pm = 32; u.pn = L - 256; return true; } return false;
    }
    __device__ __forceinline__ void a_ready(const Unit& u) const {
        if (threadIdx.x < 64) panel_wait_wave0(cnt, u.pm, u.pm == 32 ? 128u : 16u);
        asm volatile("" ::: "memory"); __builtin_amdgcn_s_barrier(); asm volatile("" ::: "memory");
    }
    __device__ __forceinline__ void done(const Unit&) const {}
};

template <class Epi, class Sched, bool ALIGN_EPI = true>
__device__ __forceinline__ void gemm_phase(LAS unsigned char* lds, const Gemm g, const Sched& S, const Epi& E) {
    int tid_ = threadIdx.x; asm volatile("" : "+v"(tid_)); const int tid = tid_, wid = __builtin_amdgcn_readfirstlane(tid >> 6), lane = tid & 63, wr = wid >> 2, wc = wid & 3, fr = lane & 15, fq = lane >> 4;
    const int K = g.K, nt = K / BK;
    unsigned voffA[2], voffB[2];
#pragma unroll
    for (int i = 0; i < 2; ++i) { int R, C; stage_rc(tid * 16 + i * 8192, R, C); const int Rb = Epi::PERM ? ((R & ~31) + perm32(R & 31)) : R;
        voffA[i] = (unsigned)(R * K + C) * 2u; voffB[i] = (unsigned)(Rb * K + C) * 2u; }
    const size_t kstep = (size_t)(BK * 2);
    const size_t hstep = (size_t)HALF * K * 2;
    const size_t tstep = 2 * hstep;
    const unsigned ldsw = (unsigned)wid * 1024u;
    const int aoff = lds_byte(wr * 64 + fr, fq * 8), boff = lds_byte(wc * 32 + fr, fq * 8);
#define PG8_SA(b, h) (((b) * 2 + (h)) * HTB)
#define PG8_SB(b, h) ((4 + (b) * 2 + (h)) * HTB)
#define PG8_STAGE(bufoff, gbase, voff) do { _Pragma("unroll") for (int _i = 0; _i < 2; ++_i) \
        __builtin_amdgcn_global_load_lds((const unsigned*)((const char*)(gbase) + (voff)[_i]), (LAS unsigned*)(lds + (bufoff) + ldsw + _i * 8192), 16, 0, 0); } while (0)
#define PG8_LDA(dst, b, h) do { _Pragma("unroll") for (int m = 0; m < 4; ++m) _Pragma("unroll") for (int k = 0; k < 2; ++k) dst[m][k] = *(const LAS bf16x8*)(lds + PG8_SA(b, h) + aoff + m * 2048 + k * 1024); } while (0)
#define PG8_LDB(dst, b, h) do { _Pragma("unroll") for (int n = 0; n < 2; ++n) _Pragma("unroll") for (int k = 0; k < 2; ++k) dst[n][k] = *(const LAS bf16x8*)(lds + PG8_SB(b, h) + boff + n * 2048 + k * 1024); } while (0)
#define PG8_MMA(ai, bj, At, Bt) do { __builtin_amdgcn_s_setprio(1); _Pragma("unroll") for (int m = 0; m < 4; ++m) _Pragma("unroll") for (int n = 0; n < 2; ++n) _Pragma("unroll") for (int k = 0; k < 2; ++k) \
        acc[ai][bj][m][n] = __builtin_amdgcn_mfma_f32_16x16x32_bf16(Bt[n][k], At[m][k], acc[ai][bj][m][n], 0, 0, 0); __builtin_amdgcn_s_setprio(0); } while (0)
#define PG8_WAIT_V(n) asm volatile("s_waitcnt vmcnt(" #n ")" ::: "memory")
#define PG8_WAIT_L(n) asm volatile("s_waitcnt lgkmcnt(" #n ")" ::: "memory")
#define PG8_BAR __builtin_amdgcn_s_barrier()
#define PG8_SCHED __builtin_amdgcn_sched_barrier(0)
    Unit cur, nxt; int ui = 0; int pend = -1;
    if (!S.next(0, cur)) return;
    f32x4 acc[2][2][4][2];
#pragma unroll
    for (int a = 0; a < 2; ++a)
#pragma unroll
        for (int b = 0; b < 2; ++b)
#pragma unroll
            for (int m = 0; m < 4; ++m)
#pragma unroll
                for (int n = 0; n < 2; ++n) acc[a][b][m][n] = (f32x4){0.f, 0.f, 0.f, 0.f};
    bf16x8 At[4][2], B0[2][2], B1[2][2];
    const char* cA = (const char*)g.A + (size_t)cur.pm * tstep; const char* cB = (const char*)g.Bt + (size_t)cur.pn * tstep;
    S.a_ready(cur);
    PG8_STAGE(PG8_SB(0, 0), cB, voffB); PG8_STAGE(PG8_SB(0, 1), cB + hstep, voffB); PG8_STAGE(PG8_SA(0, 0), cA, voffA); PG8_STAGE(PG8_SA(0, 1), cA + hstep, voffA);
    if (wr == 1) PG8_BAR;
    PG8_WAIT_V(2); PG8_BAR;
    PG8_STAGE(PG8_SB(1, 0), cB + kstep, voffB); PG8_STAGE(PG8_SA(1, 0), cA + kstep, voffA); PG8_STAGE(PG8_SB(1, 1), cB + hstep + kstep, voffB);
    PG8_WAIT_V(6); PG8_BAR;
    for (;;) {
        const bool has_next = S.next(ui + 1, nxt);
        const char* nA = has_next ? (const char*)g.A + (size_t)nxt.pm * tstep : cA; const char* nB = has_next ? (const char*)g.Bt + (size_t)nxt.pn * tstep : cB;
        for (int t = 0; t < nt; t += 2) {
            const bool last = (t == nt - 2);
            const char* a1 = cA + (size_t)(t + 1) * kstep;
            const char* a2 = last ? nA : cA + (size_t)(t + 2) * kstep; const char* b2 = last ? nB : cB + (size_t)(t + 2) * kstep;
            const char* a3 = a2 + kstep; const char* b3 = b2 + kstep;
            if (last && has_next) S.a_ready(nxt);
            if (Sched::PUBLISH && last && pend >= 0) {
                if (tid == 0) __hip_atomic_fetch_add(S.cnt + 64 * pend, 1u, __ATOMIC_RELAXED, __HIP_MEMORY_SCOPE_AGENT);
                pend = -1;
            }
            PG8_LDB(B0, 0, 0); PG8_LDB(B1, 0, 1); PG8_SCHED; PG8_LDA(At, 0, 0); PG8_STAGE(PG8_SA(1, 1), a1 + hstep, voffA);
            PG8_WAIT_V(8); PG8_WAIT_L(0); PG8_BAR; PG8_MMA(0, 0, At, B0); PG8_MMA(0, 1, At, B1); PG8_BAR; PG8_SCHED;
            PG8_LDA(At, 0, 1); PG8_STAGE(PG8_SB(0, 0), b2, voffB); PG8_STAGE(PG8_SB(0, 1), b2 + hstep, voffB); PG8_STAGE(PG8_SA(0, 0), a2, voffA);
            PG8_WAIT_V(8); PG8_WAIT_L(0); PG8_BAR; PG8_MMA(1, 0, At, B0); PG8_MMA(1, 1, At, B1); PG8_BAR; PG8_SCHED;
            PG8_LDB(B0, 1, 0); PG8_LDB(B1, 1, 1); PG8_SCHED; PG8_LDA(At, 1, 0); PG8_STAGE(PG8_SA(0, 1), a2 + hstep, voffA);
            PG8_WAIT_V(8); PG8_WAIT_L(0); PG8_BAR; PG8_MMA(0, 0, At, B0); PG8_MMA(0, 1, At, B1); PG8_BAR; PG8_SCHED;
            PG8_LDA(At, 1, 1); PG8_STAGE(PG8_SB(1, 0), b3, voffB); PG8_STAGE(PG8_SB(1, 1), b3 + hstep, voffB); PG8_STAGE(PG8_SA(1, 0), a3, voffA);
            PG8_WAIT_V(8); PG8_WAIT_L(0); PG8_BAR; PG8_MMA(1, 0, At, B0); PG8_MMA(1, 1, At, B1); PG8_BAR; PG8_SCHED;
        }
        if constexpr (ALIGN_EPI) { if (wr == 0) PG8_BAR; }
        E(acc, cur, wr, wc, fr, fq); if (Sched::PUBLISH) pend = cur.pm;
        if (!has_next) break;
#pragma unroll
        for (int a = 0; a < 2; ++a)
#pragma unroll
            for (int b = 0; b < 2; ++b)
#pragma unroll
                for (int m = 0; m < 4; ++m)
#pragma unroll
                    for (int n = 0; n < 2; ++n) acc[a][b][m][n] = (f32x4){0.f, 0.f, 0.f, 0.f};
        cur = nxt; cA = nA; cB = nB; ++ui;
        if constexpr (ALIGN_EPI) { if (wr == 1) PG8_BAR; }
    }
    PG8_WAIT_V(0);
    if constexpr (!ALIGN_EPI) { if (wr == 0) PG8_BAR; }
    PG8_BAR;
    if (Sched::PUBLISH && pend >= 0 && tid == 0) __hip_atomic_fetch_add(S.cnt + 64 * pend, 1u, __ATOMIC_RELAXED, __HIP_MEMORY_SCOPE_AGENT);
#undef PG8_SA
#undef PG8_SB
#undef PG8_STAGE
#undef PG8_LDA
#undef PG8_LDB
#undef PG8_MMA
#undef PG8_WAIT_V
#undef PG8_WAIT_L
#undef PG8_BAR
#undef PG8_SCHED
}
}

struct EpiG1 {
    static constexpr bool PERM = true;
    bf16_t* rb; f32x2* lnp; LAS f32x2* red;
    __device__ __forceinline__ void operator()(const f32x4 (&acc)[2][2][4][2], const pg8::Unit& u, int wr, int wc, int fr, int fq) const {
        const int row0 = u.pm * 256 + wr * 64 + fr;
        if (u.pn < 32) {
            const int col0 = u.pn * 128 + wc * 32 + 8 * fq;
#pragma unroll
            for (int ai = 0; ai < 2; ++ai)
#pragma unroll
                for (int m = 0; m < 4; ++m) {
                    const int row = row0 + ai * 128 + m * 16;
                    const f32x4 u0 = acc[ai][0][m][0], u1 = acc[ai][0][m][1], z0 = acc[ai][1][m][0], z1 = acc[ai][1][m][1];
                    const f32x2 a = guz2((f32x2){u0[0], u0[1]}, (f32x2){z0[0], z0[1]}), b = guz2((f32x2){u0[2], u0[3]}, (f32x2){z0[2], z0[3]});
                    const f32x2 c = guz2((f32x2){u1[0], u1[1]}, (f32x2){z1[0], z1[1]}), d = guz2((f32x2){u1[2], u1[3]}, (f32x2){z1[2], z1[3]});
                    u32x4 w; w.x = cvt_pk_bf16(a.x, a.y); w.y = cvt_pk_bf16(b.x, b.y); w.z = cvt_pk_bf16(c.x, c.y); w.w = cvt_pk_bf16(d.x, d.y);
                    st_wt16(rb + (size_t)row * GW + col0, w);
                }
        } else {
            const int pv = u.pn - 32;
            bf16_t* base = rb + SZ_G;
            const int col0 = pv * 256 + wc * 32 + 8 * fq;
#pragma unroll
            for (int ai = 0; ai < 2; ++ai)
#pragma unroll
                for (int m = 0; m < 4; ++m) {
                    const int row = row0 + ai * 128 + m * 16;
                    bf16_t* rowp = base + (size_t)row * GW + col0;
                    f32x2 s2 = (f32x2){0.f, 0.f}, q2 = s2;
#pragma unroll
                    for (int bj = 0; bj < 2; ++bj) {
                        const f32x4 x0 = acc[ai][bj][m][0], x1 = acc[ai][bj][m][1];
                        const f32x2 a = gelu2((f32x2){x0[0], x0[1]}), b = gelu2((f32x2){x0[2], x0[3]}), c = gelu2((f32x2){x1[0], x1[1]}), d = gelu2((f32x2){x1[2], x1[3]});
                        s2 += (a + b) + (c + d); q2 += (a * a + b * b) + (c * c + d * d);
                        u32x4 w; w.x = cvt_pk_bf16(a.x, a.y); w.y = cvt_pk_bf16(b.x, b.y); w.z = cvt_pk_bf16(c.x, c.y); w.w = cvt_pk_bf16(d.x, d.y);
                        st_wt16(rowp + bj * 128, w);
                    }
                    float s = s2.x + s2.y, q = q2.x + q2.y;
                    s += __shfl_xor(s, 16); s += __shfl_xor(s, 32); q += __shfl_xor(q, 16); q += __shfl_xor(q, 32);
                    if (fq == 0) red[(ai * 128 + wr * 64 + m * 16 + fr) * 4 + wc] = (f32x2){s, q};
                }
            asm volatile("s_waitcnt lgkmcnt(0)" ::: "memory"); __builtin_amdgcn_s_barrier(); asm volatile("" ::: "memory");
            if (threadIdx.x < 256) {
                const int r = threadIdx.x; const f32x2 a = red[r * 4 + 0], b = red[r * 4 + 1], c = red[r * 4 + 2], d = red[r * 4 + 3];
                st_wt8(lnp + (size_t)(u.pm * 256 + r) * 16 + pv, (u32x2){__float_as_uint((a[0] + b[0]) + (c[0] + d[0])), __float_as_uint((a[1] + b[1]) + (c[1] + d[1]))});
            }
        }
    }
};
template <bool FIRST> struct EpiRes {
    static constexpr bool PERM = false;
    const float* xp; const float* xs; float* oy; bf16_t* xb; float* ss;
    __device__ __forceinline__ void operator()(const f32x4 (&acc)[2][2][4][2], const pg8::Unit& u, int wr, int wc, int fr, int fq) const {
        const int row0 = u.pm * 256 + wr * 64 + fr, col0 = u.pn * 256 + wc * 32 + 4 * fq;
#pragma unroll
        for (int ai = 0; ai < 2; ++ai)
#pragma unroll
            for (int m = 0; m < 4; ++m) {
                const int row = row0 + ai * 128 + m * 16;
                float* orow = oy + (size_t)row * DM + col0;
                const float* xr = FIRST ? ((row < MP ? xp + (size_t)row * DM : xs + (size_t)(row - MP) * DM) + col0) : orow;
                float q = 0.f;
#pragma unroll
                for (int bj = 0; bj < 2; ++bj)
#pragma unroll
                    for (int n = 0; n < 2; ++n) {
                        const f32x4 xv = *(const f32x4*)(xr + bj * 128 + n * 16);
                        const f32x4 o = xv + acc[ai][bj][m][n];
                        *(f32x4*)(orow + bj * 128 + n * 16) = o;
                        q += (o[0] * o[0] + o[1] * o[1]) + (o[2] * o[2] + o[3] * o[3]);
                        if (FIRST) { u32x2 w; w.x = cvt_pk_bf16(o[0], o[1]); w.y = cvt_pk_bf16(o[2], o[3]); st_wt8(xb + (size_t)row * DM + col0 + bj * 128 + n * 16, w); }
                    }
                q += __shfl_xor(q, 16); q += __shfl_xor(q, 32);
                if (fq == 0) { if (FIRST) st_wt4(ss + (size_t)row * 32 + u.pn * 4 + wc, __float_as_uint(q)); else ss[(size_t)row * 32 + u.pn * 4 + wc] = q; }
            }
    }
};
struct EpiFinal {
    static constexpr bool PERM = false;
    float* oy; float* ss; const float* fng; unsigned* cnt;
    __device__ __forceinline__ void operator()(f32x4 (&acc)[2][2][4][2], const pg8::Unit& u, int wr, int wc, int fr, int fq) const {
        const int row0 = u.pm * 256 + wr * 64 + fr, col0 = u.pn * 256 + wc * 32 + 4 * fq;
#pragma unroll
        for (int ai = 0; ai < 2; ++ai)
#pragma unroll
            for (int m = 0; m < 4; ++m) {
                const int row = row0 + ai * 128 + m * 16;
                const float* xr = oy + (size_t)row * DM + col0;
                float q = 0.f;
#pragma unroll
                for (int bj = 0; bj < 2; ++bj)
#pragma unroll
                    for (int n = 0; n < 2; ++n) {
                        const f32x4 o = *(const f32x4*)(xr + bj * 128 + n * 16) + acc[ai][bj][m][n];
                        acc[ai][bj][m][n] = o;
                        q += (o[0] * o[0] + o[1] * o[1]) + (o[2] * o[2] + o[3] * o[3]);
                    }
                q += __shfl_xor(q, 16); q += __shfl_xor(q, 32);
                if (fq == 0) st_wt4(ss + (size_t)row * 32 + u.pn * 4 + wc, __float_as_uint(q));
            }
        asm volatile("s_waitcnt vmcnt(0)" ::: "memory");
        __builtin_amdgcn_s_barrier();
        if (threadIdx.x < 64) {
            if (threadIdx.x == 0) __hip_atomic_fetch_add(cnt + 64 * u.pm, 1u, __ATOMIC_RELAXED, __HIP_MEMORY_SCOPE_AGENT);
            pg8::panel_wait_wave0(cnt, u.pm, 8u);
        }
        asm volatile("" ::: "memory"); __builtin_amdgcn_s_barrier(); asm volatile("" ::: "memory");
        f32x4 gg[2][2];
#pragma unroll
        for (int bj = 0; bj < 2; ++bj)
#pragma unroll
            for (int n = 0; n < 2; ++n) gg[bj][n] = *(const f32x4*)(fng + col0 + bj * 128 + n * 16);
#pragma unroll
        for (int ai = 0; ai < 2; ++ai)
#pragma unroll
            for (int m = 0; m < 4; ++m) {
                const int row = row0 + ai * 128 + m * 16;
                const f32x4 pa = *(const f32x4*)(ss + (size_t)row * 32 + 8 * fq), pb = *(const f32x4*)(ss + (size_t)row * 32 + 8 * fq + 4);
                float sq = ((pa[0] + pa[1]) + (pa[2] + pa[3])) + ((pb[0] + pb[1]) + (pb[2] + pb[3]));
                sq += __shfl_xor(sq, 16); sq += __shfl_xor(sq, 32);
                const float rinv = __builtin_amdgcn_rsqf(sq * (1.0f / DM) + 1e-6f);
                float* orow = oy + (size_t)row * DM + col0;
#pragma unroll
                for (int bj = 0; bj < 2; ++bj)
#pragma unroll
                    for (int n = 0; n < 2; ++n) *(f32x4*)(orow + bj * 128 + n * 16) = acc[ai][bj][m][n] * rinv * gg[bj][n];
            }
    }
};
struct EpiG3 {
    static constexpr bool PERM = true;
    bf16_t* rb; const float* ss1; float* out;
    __device__ __forceinline__ void operator()(const f32x4 (&acc)[2][2][4][2], const pg8::Unit& u, int wr, int wc, int fr, int fq) const {
        const int t = u.pn >> 3;
        bf16_t* base = rb + (size_t)t * SZ_D;
        const int row0 = u.pm * 256 + wr * 64 + fr, col0 = (u.pn & 7) * 256 + wc * 32 + 8 * fq;
#pragma unroll
        for (int ai = 0; ai < 2; ++ai)
#pragma unroll
            for (int m = 0; m < 4; ++m) {
                const int row = row0 + ai * 128 + m * 16;
                const f32x4 pa = *(const f32x4*)(ss1 + (size_t)row * 32 + 8 * fq), pb = *(const f32x4*)(ss1 + (size_t)row * 32 + 8 * fq + 4);
                float s = ((pa[0] + pa[1]) + (pa[2] + pa[3])) + ((pb[0] + pb[1]) + (pb[2] + pb[3]));
                s += __shfl_xor(s, 16); s += __shfl_xor(s, 32);
                float rinv = __builtin_amdgcn_rsqf(s * (1.0f / DM) + 1e-6f);
                if (t == 0) rinv *= 0.08838834764831845f * 1.4426950408889634f;
                bf16_t* rowp = base + (size_t)row * DM + col0;
                float* fo = nullptr;
                if (t == 1) fo = out + (row < MP ? O_KP + (size_t)row * DM : O_KS + (size_t)(row - MP) * DM) + col0;
                if (t == 2) fo = out + (row < MP ? O_VP + (size_t)row * DM : O_VS + (size_t)(row - MP) * DM) + col0;
#pragma unroll
                for (int bj = 0; bj < 2; ++bj) {
                    f32x4 v0 = acc[ai][bj][m][0] * rinv, v1 = acc[ai][bj][m][1] * rinv;
                    if (t == 3) {
                        const f32x2 a = silu2((f32x2){v0[0], v0[1]}), b = silu2((f32x2){v0[2], v0[3]}), c = silu2((f32x2){v1[0], v1[1]}), d = silu2((f32x2){v1[2], v1[3]});
                        v0 = (f32x4){a.x, a.y, b.x, b.y}; v1 = (f32x4){c.x, c.y, d.x, d.y};
                    }
                    if (t == 1 || t == 2) { *(f32x4*)(fo + bj * 128) = v0; *(f32x4*)(fo + bj * 128 + 4) = v1; }
                    u32x4 w; w.x = cvt_pk_bf16(v0[0], v0[1]); w.y = cvt_pk_bf16(v0[2], v0[3]); w.z = cvt_pk_bf16(v1[0], v1[1]); w.w = cvt_pk_bf16(v1[2], v1[3]);
                    *(u32x4*)(rowp + bj * 128) = w;
                }
            }
    }
};

__device__ __forceinline__ void p0_transpose_item(const float* W, int K, int N, bf16_t* WT, const float* gk, LAS float* scr, int item, int lane, bool w1map) {
    const int nblk = N / 32, kb = item / nblk, nb = item % nblk, k0 = 64 * kb, n0 = 32 * nb;
    int nd0 = n0;
    if (w1map) { if (n0 < GW) nd0 = (n0 >> 7) * 256 + (n0 & 127); else if (n0 < 2 * GW) nd0 = 2 * GW + (n0 - GW); else { const int c = n0 - 2 * GW; nd0 = (c >> 7) * 256 + 128 + (c & 127); } }
    float wv[32];
#pragma unroll
    for (int i = 0; i < 32; ++i) wv[i] = W[(size_t)(k0 + 2 * i + (lane >> 5)) * N + n0 + (lane & 31)];
    if (gk) {
#pragma unroll
        for (int i = 0; i < 32; ++i) wv[i] *= gk[k0 + 2 * i + (lane >> 5)];
    }
#pragma unroll
    for (int i = 0; i < 32; ++i) scr[(2 * i + (lane >> 5)) * 33 + (lane & 31)] = wv[i];
    asm volatile("s_waitcnt lgkmcnt(0)" ::: "memory");
    const int c = lane & 7;
#pragma unroll
    for (int j = 0; j < 4; ++j) { const int n = (lane >> 3) + 8 * j; const LAS float* s = scr + (8 * c) * 33 + n;
        u32x4 o; o.x = cvt_pk_bf16(s[0 * 33], s[1 * 33]); o.y = cvt_pk_bf16(s[2 * 33], s[3 * 33]); o.z = cvt_pk_bf16(s[4 * 33], s[5 * 33]); o.w = cvt_pk_bf16(s[6 * 33], s[7 * 33]);
        *(u32x4*)(WT + (size_t)(nd0 + n) * K + k0 + 8 * c) = o; }
    asm volatile("s_waitcnt lgkmcnt(0)" ::: "memory");
}
__device__ __forceinline__ void p0_prologue(const Params& p, LAS unsigned char* lds, int G) {
    int tid_ = threadIdx.x; asm volatile("" : "+v"(tid_)); const int tid = tid_, lane = tid & 63, wave = tid >> 6;
    LAS float* scr = (LAS float*)(lds + wave * 16384);
    const int gw = blockIdx.x * 8 + wave, NGW = G * 8;
    bf16_t* W1T = (bf16_t*)(p.ws + WS_W1T); bf16_t* W2T = (bf16_t*)(p.ws + WS_W2T); bf16_t* W3T = (bf16_t*)(p.ws + WS_W3T); bf16_t* W4T = (bf16_t*)(p.ws + WS_W4T);
    constexpr int I1 = (DM / 64) * (N1 / 32), I2 = (GW / 64) * (DM / 32), I3 = (DM / 64) * (N3 / 32), I4 = (DM / 64) * (DM / 32);
    bf16_t* h0 = (bf16_t*)(p.ws + WS_RA);
    for (int m = gw; m < MT; m += NGW) {
        const float* xrow = (m < MP) ? p.xp + (size_t)m * DM : p.xs + (size_t)(m - MP) * DM;
        f32x4 v[8]; float s = 0.f;
#pragma unroll
        for (int j = 0; j < 8; ++j) { v[j] = *(const f32x4*)(xrow + 4 * lane + 256 * j); s += (v[j][0] * v[j][0] + v[j][1] * v[j][1]) + (v[j][2] * v[j][2] + v[j][3] * v[j][3]); }
        const float rinv = __builtin_amdgcn_rsqf(wave_sum(s) * (1.0f / DM) + 1e-6f);
#pragma unroll
        for (int j = 0; j < 8; ++j) { const f32x4 gg = *(const f32x4*)(p.norm_g + 4 * lane + 256 * j);
            u32x2 w; w.x = cvt_pk_bf16(v[j][0] * rinv * gg[0], v[j][1] * rinv * gg[1]); w.y = cvt_pk_bf16(v[j][2] * rinv * gg[2], v[j][3] * rinv * gg[3]);
            *(u32x2*)(h0 + (size_t)m * DM + 4 * lane + 256 * j) = w; }
    }
    for (int it = gw; it < I1 + I2 + I3 + I4; it += NGW) {
        int r = it;
        if (r < I1) { p0_transpose_item(p.w1, DM, N1, W1T, nullptr, scr, r, lane, true); continue; } r -= I1;
        if (r < I2) { p0_transpose_item(p.w2, GW, DM, W2T, nullptr, scr, r, lane, false); continue; } r -= I2;
        if (r < I3) { p0_transpose_item(p.w3, DM, N3, W3T, p.norm_g + DM, scr, r, lane, false); continue; } r -= I3;
        p0_transpose_item(p.w4, DM, DM, W4T, nullptr, scr, r, lane, false);
    }
}

constexpr int MIX_WP = 136, MIX_VP = 264;
constexpr int MIX_W_OFF = 0, MIX_V_OFF = 128 * MIX_WP * 2, MIX_ST_OFF = MIX_V_OFF + 128 * MIX_VP * 2;
__device__ __forceinline__ void mix_phase(const Params& p, LAS unsigned char* lds, int G, bool dry) {
    int tid_ = threadIdx.x; asm volatile("" : "+v"(tid_)); const int tid = tid_, wid = tid >> 6, lane = tid & 63, wr = wid >> 2, wc = wid & 3, fr = lane & 15, fq = lane >> 4;
    bf16_t* gu = (bf16_t*)(p.ws + WS_RB); const bf16_t* gv = gu + SZ_G;
    const f32x2* lnp = (const f32x2*)(p.ws + WS_LNP);
    LAS bf16_t* Wl = (LAS bf16_t*)(lds + MIX_W_OFF); LAS bf16_t* Vl = (LAS bf16_t*)(lds + MIX_V_OFF); LAS float* st = (LAS float*)(lds + MIX_ST_OFF);
    unsigned* ctr = (unsigned*)(p.ws + WS_CTL) + 2; unsigned* pcnt = (unsigned*)(p.ws + WS_CTL) + 11264;
    volatile LAS int* misc = (volatile LAS int*)(lds + MIX_ST_OFF + 1024);
    unsigned long long seen = 0ull;
    if (tid == 0) misc[0] = (int)atomicAdd(ctr, 1u);
    for (;;) {
        __syncthreads();
        const int unit = misc[0];
        if (unit >= 66 * 16) break;
        const int nb = unit >> 4, g = unit & 15, row_base = nb * 128; const bool smp = nb >= 64;
        if (!((seen >> (nb >> 1)) & 1ull)) {
            if (tid < 64) pg8::panel_wait_wave0(pcnt, nb >> 1, 48u);
            seen |= 1ull << (nb >> 1);
        }
        __syncthreads();
        int nticket = 0;
        if (tid == 0) nticket = (int)atomicAdd(ctr, 1u);
        u32x4 raw[8];
#pragma unroll
        for (int i = 0; i < 8; ++i) { const int cid = tid + 512 * i, s = cid >> 5, c = (cid & 31) * 8; raw[i] = *(const u32x4*)(gv + (size_t)(row_base + s) * GW + g * 256 + c); }
        const int t = tid >> 2, s0 = (tid & 3) * 32; bool on; const float* src;
        if (smp) { on = (t >> 5) == (tid & 3); src = p.wsp + ((size_t)g * 128 + (t & 31)) * 128; }
        else { on = (s0 >> 6) <= (t >> 6); src = p.wsp + ((size_t)g * 128 + t) * 128 + s0; }
        f32x4 wa[8];
#pragma unroll
        for (int j = 0; j < 8; ++j) wa[j] = on ? *(const f32x4*)(src + 4 * j) : (f32x4){0.f, 0.f, 0.f, 0.f};
        float ssum = 0.f, qsum = 0.f;
        {   const f32x4* pp = (const f32x4*)(lnp + (size_t)(row_base + t) * 16) + (tid & 3) * 2;
#pragma unroll
            for (int i = 0; i < 2; ++i) { const f32x4 a = pp[i]; ssum += a[0] + a[2]; qsum += a[1] + a[3]; } }
        const int cc = g * 256 + (tid & 31) * 8;
        const f32x4 g0 = *(const f32x4*)(p.lng + cc), g1 = *(const f32x4*)(p.lng + cc + 4), b0 = *(const f32x4*)(p.lnb + cc), b1 = *(const f32x4*)(p.lnb + cc + 4);
        ssum += __shfl_xor(ssum, 1); qsum += __shfl_xor(qsum, 1); ssum += __shfl_xor(ssum, 2); qsum += __shfl_xor(qsum, 2);
        if ((tid & 3) == 0) { const float mean = ssum * (1.0f / GW), var = qsum * (1.0f / GW) - mean * mean; st[t] = mean; st[128 + t] = __builtin_amdgcn_rsqf(var + 1e-5f); }
#pragma unroll
        for (int j = 0; j < 4; ++j) { const f32x4 a = wa[2 * j], b2 = wa[2 * j + 1];
            u32x4 w; w.x = cvt_pk_bf16(a[0], a[1]); w.y = cvt_pk_bf16(a[2], a[3]); w.z = cvt_pk_bf16(b2[0], b2[1]); w.w = cvt_pk_bf16(b2[2], b2[3]);
            *(LAS u32x4*)(Wl + t * MIX_WP + s0 + 8 * j) = w; }
        __syncthreads();
#pragma unroll
        for (int i = 0; i < 8; ++i) {
            const int cid = tid + 512 * i, s = cid >> 5, c = (cid & 31) * 8;
            const float mu = st[s], rs = st[128 + s];
            f32x4 x0 = (f32x4){bf_lo(raw[i].x), bf_hi(raw[i].x), bf_lo(raw[i].y), bf_hi(raw[i].y)}, x1 = (f32x4){bf_lo(raw[i].z), bf_hi(raw[i].z), bf_lo(raw[i].w), bf_hi(raw[i].w)};
            x0 = (x0 - mu) * rs * g0 + b0; x1 = (x1 - mu) * rs * g1 + b1;
            if (smp) { float* o = p.out + O_GMV + (size_t)(row_base - MP + s) * GW + g * 256 + c; *(f32x4*)o = x0; *(f32x4*)(o + 4) = x1; }
            u32x4 w; w.x = cvt_pk_bf16(x0[0], x0[1]); w.y = cvt_pk_bf16(x0[2], x0[3]); w.z = cvt_pk_bf16(x1[0], x1[1]); w.w = cvt_pk_bf16(x1[2], x1[3]);
            *(LAS u32x4*)(Vl + s * MIX_VP + c) = w;
        }
        u32x2 ur[4][4]; float bias[4];
        bf16_t* const gup = gu + (size_t)(row_base + 64 * wr + fr) * GW + g * 256 + 64 * wc + 4 * fq;
#pragma unroll
        for (int m = 0; m < 4; ++m) {
            const int tt = 64 * wr + 16 * m + fr; bias[m] = p.bsp[g * 128 + (smp ? (tt & 31) : tt)];
#pragma unroll
            for (int n = 0; n < 4; ++n) ur[m][n] = *(const u32x2*)(gup + (size_t)m * 16 * GW + 16 * n);
        }
        __syncthreads();
        f32x4 acc[4][4];
#pragma unroll
        for (int m = 0; m < 4; ++m)
#pragma unroll
            for (int n = 0; n < 4; ++n) acc[m][n] = (f32x4){0.f, 0.f, 0.f, 0.f};
#pragma unroll
        for (int ks = 0; ks < 4; ++ks) {
            bf16x8 af[4], bfr[4];
#pragma unroll
            for (int m = 0; m < 4; ++m) af[m] = *(const LAS bf16x8*)(Wl + (64 * wr + 16 * m + fr) * MIX_WP + 32 * ks + 8 * fq);
#pragma unroll
            for (int n = 0; n < 4; ++n) {
                const LAS bf16_t* a0 = Vl + (32 * ks + 8 * fq + (fr >> 2)) * MIX_VP + 64 * wc + 16 * n + 4 * (fr & 3);
                const s16x4 lo = __builtin_amdgcn_ds_read_tr16_b64_v4i16((LAS s16x4*)a0), hi = __builtin_amdgcn_ds_read_tr16_b64_v4i16((LAS s16x4*)(a0 + 4 * MIX_VP));
                bfr[n] = (bf16x8){lo[0], lo[1], lo[2], lo[3], hi[0], hi[1], hi[2], hi[3]};
            }
#pragma unroll
            for (int m = 0; m < 4; ++m)
#pragma unroll
                for (int n = 0; n < 4; ++n) acc[m][n] = __builtin_amdgcn_mfma_f32_16x16x32_bf16(bfr[n], af[m], acc[m][n], 0, 0, 0);
        }
#pragma unroll
        for (int m = 0; m < 4; ++m) {
#pragma unroll
            for (int n = 0; n < 4; ++n) {
                const f32x4 a = acc[m][n] + bias[m]; const u32x2 u2 = ur[m][n];
                u32x2 w; w.x = cvt_pk_bf16(bf_lo(u2.x) * a[0], bf_hi(u2.x) * a[1]); w.y = cvt_pk_bf16(bf_lo(u2.y) * a[2], bf_hi(u2.y) * a[3]);
                if (!dry) *(u32x2*)(gup + (size_t)m * 16 * GW + 16 * n) = w;
            }
        }
        if (tid == 0) misc[0] = nticket;
    }
}

constexpr int AT_P = 136;
constexpr int AT_K_OFF = 0, AT_V_OFF = 64 * AT_P * 2, AT_MISC_OFF = 2 * 64 * AT_P * 2;
constexpr int AT_ITEMS = 512 + 128;
__device__ __forceinline__ void attn_phase(const Params& p, LAS unsigned char* lds, int cidx) {
    int tid_ = threadIdx.x; asm volatile("" : "+v"(tid_)); const int tid = tid_, wid = __builtin_amdgcn_readfirstlane(tid >> 6), lane = tid & 63, fr = lane & 15, fq = lane >> 4;
    const bf16_t* qb = (const bf16_t*)(p.ws + WS_RB) + 2 * SZ_D; const bf16_t* kb = qb + SZ_D; const bf16_t* vb = qb + 2 * SZ_D; const bf16_t* sz1 = qb + 3 * SZ_D; bf16_t* y1 = (bf16_t*)(p.ws + WS_RB);
    unsigned* ctr = (unsigned*)(p.ws + WS_CTL) + cidx; unsigned* pcnt = (unsigned*)(p.ws + WS_CTL) + 8192;
    LAS bf16_t* Kl = (LAS bf16_t*)(lds + AT_K_OFF); LAS bf16_t* Vl = (LAS bf16_t*)(lds + AT_V_OFF); volatile LAS int* misc = (volatile LAS int*)(lds + AT_MISC_OFF);
    int prev_pm = -1, cur_pm = -1;
    for (;;) {
        __syncthreads();
        if (tid == 0) misc[0] = (int)atomicAdd(ctr, 1u);
        __syncthreads();
        const int item = misc[0];
        if (item >= AT_ITEMS) break;
        prev_pm = cur_pm;
        const bool smp = item < 128;
        int b, h, x, kt_hi, qrow0, tpos0; size_t krow0;
        if (!smp) { const int it = item - 128; x = 7 - (it >> 6); const int bh = it & 63; b = bh >> 4; h = bh & 15; kt_hi = 4 * x + 3; qrow0 = b * 2048 + x * 256 + 32 * wid; tpos0 = x * 256 + 32 * wid; krow0 = (size_t)b * 2048; cur_pm = b * 8 + x; }
        else { x = 0; const int bh = item; b = bh >> 4; h = bh & 15; kt_hi = 16; qrow0 = MP + b * 32; tpos0 = 1024; krow0 = 0; cur_pm = 32; }
        const bool active = !smp || wid == 0;
        bf16x8 qf[2][4];
#pragma unroll
        for (int mt = 0; mt < 2; ++mt)
#pragma unroll
            for (int kk = 0; kk < 4; ++kk) qf[mt][kk] = *(const bf16x8*)(qb + (size_t)(qrow0 + 16 * mt + fr) * DM + h * 128 + 32 * kk + 8 * fq);
        f32x4 o[2][8];
#pragma unroll
        for (int mt = 0; mt < 2; ++mt)
#pragma unroll
            for (int dt = 0; dt < 8; ++dt) o[mt][dt] = (f32x4){0.f, 0.f, 0.f, 0.f};
        float C[2] = {0.f, 0.f};
        bool wdone = !active;
        if (lane == 0) misc[8 + wid] = wdone ? 1 : 0;
        f32x4 pf[2][4];
        if (!smp) {
#pragma unroll
            for (int i = 0; i < 2; ++i) { const int cid = tid + 512 * i, key = cid >> 4, d8 = (cid & 15) * 8; const size_t off = (krow0 + kt_hi * 64 + key) * DM + h * 128 + d8;
                pf[i][0] = __builtin_bit_cast(f32x4, *(const u32x4*)(kb + off)); pf[i][2] = __builtin_bit_cast(f32x4, *(const u32x4*)(vb + off)); }
        }
        for (int kt = kt_hi; kt >= 0; --kt) {
            __syncthreads();
            {
                int alld = 1;
#pragma unroll
                for (int w = 0; w < 8; ++w) alld &= misc[8 + w];
                if (alld) break;
            }
#pragma unroll
            for (int i = 0; i < 2; ++i) {
                const int cid = tid + 512 * i, key = cid >> 4, d8 = (cid & 15) * 8;
                u32x4 kwv, vwv;
                if (!smp) { kwv = __builtin_bit_cast(u32x4, pf[i][0]); vwv = __builtin_bit_cast(u32x4, pf[i][2]); }
                else if (kt == 16) {
                    if (key < 32) { const size_t off = (size_t)(MP + b * 32 + key) * DM + h * 128 + d8; kwv = *(const u32x4*)(kb + off); vwv = *(const u32x4*)(vb + off); }
                    else { kwv = (u32x4){0u, 0u, 0u, 0u}; vwv = kwv; }
                } else {
                    const f32x4 k0 = pf[i][0], k1 = pf[i][1], v0 = pf[i][2], v1 = pf[i][3];
                    kwv.x = cvt_pk_bf16(k0[0], k0[1]); kwv.y = cvt_pk_bf16(k0[2], k0[3]); kwv.z = cvt_pk_bf16(k1[0], k1[1]); kwv.w = cvt_pk_bf16(k1[2], k1[3]);
                    vwv.x = cvt_pk_bf16(v0[0], v0[1]); vwv.y = cvt_pk_bf16(v0[2], v0[3]); vwv.z = cvt_pk_bf16(v1[0], v1[1]); vwv.w = cvt_pk_bf16(v1[2], v1[3]);
                }
                *(LAS u32x4*)(Kl + key * AT_P + d8) = kwv; *(LAS u32x4*)(Vl + key * AT_P + d8) = vwv;
            }
            if (kt > 0) {
#pragma unroll
                for (int i = 0; i < 2; ++i) {
                    const int cid = tid + 512 * i, key = cid >> 4, d8 = (cid & 15) * 8;
                    if (!smp) { const size_t off = (krow0 + (kt - 1) * 64 + key) * DM + h * 128 + d8; pf[i][0] = __builtin_bit_cast(f32x4, *(const u32x4*)(kb + off)); pf[i][2] = __builtin_bit_cast(f32x4, *(const u32x4*)(vb + off)); }
                    else { const size_t off = (((size_t)b * 1024 + (kt - 1) * 64 + key) * 16 + h) * 128 + d8;
                        pf[i][0] = *(const f32x4*)(p.ck + off); pf[i][1] = *(const f32x4*)(p.ck + off + 4); pf[i][2] = *(const f32x4*)(p.cv + off); pf[i][3] = *(const f32x4*)(p.cv + off + 4); }
                }
            }
            __syncthreads();
            if (!wdone && kt * 64 < tpos0 + 31) {
                f32x4 st[2][4];
#pragma unroll
                for (int mt = 0; mt < 2; ++mt)
#pragma unroll
                    for (int n = 0; n < 4; ++n) st[mt][n] = (f32x4){0.f, 0.f, 0.f, 0.f};
#pragma unroll
                for (int kk = 0; kk < 4; ++kk)
#pragma unroll
                    for (int n = 0; n < 4; ++n) {
                        const bf16x8 kf = *(const LAS bf16x8*)(Kl + (16 * (fr >> 2) + 4 * n + (fr & 3)) * AT_P + 32 * kk + 8 * fq);
                        st[0][n] = __builtin_amdgcn_mfma_f32_16x16x32_bf16(kf, qf[0][kk], st[0][n], 0, 0, 0);
                        st[1][n] = __builtin_amdgcn_mfma_f32_16x16x32_bf16(kf, qf[1][kk], st[1][n], 0, 0, 0);
                    }
                bf16x8 pb[2][2];
                {
                    const int s0 = kt * 64 + 16 * fq, tq0 = tpos0 + fr, tq1 = tpos0 + 16 + fr;
                    f32x2 run = (f32x2){0.f, 0.f};
#pragma unroll
                    for (int idx = 15; idx >= 0; --idx) {
                        const f32x2 xv = (f32x2){st[0][idx >> 2][idx & 3], st[1][idx >> 2][idx & 3]};
                        const f32x2 ax = __builtin_elementwise_abs(xv);
                        f32x2 e; e.x = __builtin_amdgcn_exp2f(-ax.x); e.y = __builtin_amdgcn_exp2f(-ax.y);
                        const f32x2 e1 = e + 1.0f;
                        f32x2 lg; lg.x = __builtin_amdgcn_logf(e1.x); lg.y = __builtin_amdgcn_logf(e1.y);
                        const f32x2 sp = __builtin_elementwise_max(xv, (f32x2){0.f, 0.f}) + lg;
                        const f32x2 lw = (xv - sp) + run;
                        st[0][idx >> 2][idx & 3] = lw.x; st[1][idx >> 2][idx & 3] = lw.y;
                        f32x2 dec; dec.x = (s0 + idx) < tq0 ? sp.x : 0.f; dec.y = (s0 + idx) < tq1 ? sp.y : 0.f;
                        run = run - dec;
                    }
                    f32x2 t16, t32, t48;
                    t16.x = __shfl(run.x, (lane + 16) & 63); t16.y = __shfl(run.y, (lane + 16) & 63);
                    t32.x = __shfl(run.x, (lane + 32) & 63); t32.y = __shfl(run.y, (lane + 32) & 63);
                    t48.x = __shfl(run.x, (lane + 48) & 63); t48.y = __shfl(run.y, (lane + 48) & 63);
                    const f32x2 z2 = (f32x2){0.f, 0.f};
                    const f32x2 higher = (fq < 3 ? t16 : z2) + (fq < 2 ? t32 : z2) + (fq < 1 ? t48 : z2);
                    const f32x2 base = (f32x2){C[0], C[1]} + higher;
                    const f32x2 tot = (run + t16) + (t32 + t48);
                    C[0] += tot.x; C[1] += tot.y;
                    float w0[16], w1[16];
#pragma unroll
                    for (int idx = 0; idx < 16; ++idx) {
                        const f32x2 a2 = (f32x2){st[0][idx >> 2][idx & 3], st[1][idx >> 2][idx & 3]} + base;
                        w0[idx] = (s0 + idx) < tq0 ? __builtin_amdgcn_exp2f(a2.x) : 0.f;
                        w1[idx] = (s0 + idx) < tq1 ? __builtin_amdgcn_exp2f(a2.y) : 0.f;
                    }
#pragma unroll
                    for (int k2 = 0; k2 < 2; ++k2) {
                        u32x4 pw; pw.x = cvt_pk_bf16(w0[8 * k2 + 0], w0[8 * k2 + 1]); pw.y = cvt_pk_bf16(w0[8 * k2 + 2], w0[8 * k2 + 3]); pw.z = cvt_pk_bf16(w0[8 * k2 + 4], w0[8 * k2 + 5]); pw.w = cvt_pk_bf16(w0[8 * k2 + 6], w0[8 * k2 + 7]);
                        pb[0][k2] = __builtin_bit_cast(bf16x8, pw);
                        u32x4 pv; pv.x = cvt_pk_bf16(w1[8 * k2 + 0], w1[8 * k2 + 1]); pv.y = cvt_pk_bf16(w1[8 * k2 + 2], w1[8 * k2 + 3]); pv.z = cvt_pk_bf16(w1[8 * k2 + 4], w1[8 * k2 + 5]); pv.w = cvt_pk_bf16(w1[8 * k2 + 6], w1[8 * k2 + 7]);
                        pb[1][k2] = __builtin_bit_cast(bf16x8, pv);
                    }
                }
#pragma unroll
                for (int k2 = 0; k2 < 2; ++k2)
#pragma unroll
                    for (int dt = 0; dt < 8; ++dt) {
                        const LAS bf16_t* a0 = Vl + (16 * fq + 8 * k2 + (fr >> 2)) * AT_P + 16 * dt + 4 * (fr & 3);
                        const s16x4 lo = __builtin_amdgcn_ds_read_tr16_b64_v4i16((LAS s16x4*)a0), hi = __builtin_amdgcn_ds_read_tr16_b64_v4i16((LAS s16x4*)(a0 + 4 * AT_P));
                        const bf16x8 vf = (bf16x8){lo[0], lo[1], lo[2], lo[3], hi[0], hi[1], hi[2], hi[3]};
                        o[0][dt] = __builtin_amdgcn_mfma_f32_16x16x32_bf16(vf, pb[0][k2], o[0][dt], 0, 0, 0);
                        o[1][dt] = __builtin_amdgcn_mfma_f32_16x16x32_bf16(vf, pb[1][k2], o[1][dt], 0, 0, 0);
                    }
                if (__builtin_amdgcn_ballot_w64(C[0] < -160.f && C[1] < -160.f) == ~0ull) { wdone = true;     if (lane == 0) misc[8 + wid] = 1; }
            }
        }
        asm volatile("s_waitcnt vmcnt(0)" ::: "memory");
        __syncthreads();
        if (tid == 0 && prev_pm >= 0) __hip_atomic_fetch_add(pcnt + 64 * prev_pm, 1u, __ATOMIC_RELAXED, __HIP_MEMORY_SCOPE_AGENT);
        if (active) {
#pragma unroll
            for (int mt = 0; mt < 2; ++mt)
#pragma unroll
                for (int dt = 0; dt < 8; ++dt) {
                    const size_t off = (size_t)(qrow0 + 16 * mt + fr) * DM + h * 128 + 16 * dt + 4 * fq;
                    const u32x2 zr = *(const u32x2*)(sz1 + off); const f32x4 a = o[mt][dt];
                    u32x2 w; w.x = cvt_pk_bf16(a[0] * bf_lo(zr.x), a[1] * bf_hi(zr.x)); w.y = cvt_pk_bf16(a[2] * bf_lo(zr.y), a[3] * bf_hi(zr.y));
                    st_wt8(y1 + off, w);
                }
        }
        if (smp) {
            asm volatile("s_waitcnt vmcnt(0)" ::: "memory");
            __syncthreads();
            if (tid == 0) __hip_atomic_fetch_add(pcnt + 64 * 32, 1u, __ATOMIC_RELAXED, __HIP_MEMORY_SCOPE_AGENT);
            cur_pm = -1;
        }
    }
    asm volatile("s_waitcnt vmcnt(0)" ::: "memory");
    __syncthreads();
    if (tid == 0 && cur_pm >= 0) __hip_atomic_fetch_add(pcnt + 64 * cur_pm, 1u, __ATOMIC_RELAXED, __HIP_MEMORY_SCOPE_AGENT);
}

__device__ __forceinline__ void final_phase(const Params& p, int G) {
    int tid_ = threadIdx.x; asm volatile("" : "+v"(tid_)); const int tid = tid_, lane = tid & 63, wave = tid >> 6;
    const float* ss2 = (const float*)(p.ws + WS_SS2);
    for (int m = blockIdx.x * 8 + wave; m < MT; m += G * 8) {
        const float s = wave_sum(lane < 32 ? ss2[(size_t)m * 32 + lane] : 0.f);
        const float rinv = __builtin_amdgcn_rsqf(s * (1.0f / DM) + 1e-6f);
        float* row = p.out + (size_t)m * DM;
#pragma unroll
        for (int j = 0; j < 8; ++j) { const f32x4 v = *(const f32x4*)(row + 4 * lane + 256 * j), gg = *(const f32x4*)(p.fng + 4 * lane + 256 * j); *(f32x4*)(row + 4 * lane + 256 * j) = v * rinv * gg; }
    }
}


#define XB_TMO      128
#define XB_XCNT(j)  (256  + 64 * (j))
#define XB_XSUB(j)  (1280 + 64 * (j))
#define XB_XGEN(j)  (2304 + 64 * (j))
#define XB_TOP      3328
#define XB_TOPGEN   3392
#define XCD_BAR_WORDS 3456
#define XB_SPIN_CAP (1u << 20)
__device__ __forceinline__ unsigned xb_ld(unsigned* p)              { return __hip_atomic_load(p, __ATOMIC_RELAXED, __HIP_MEMORY_SCOPE_AGENT); }
__device__ __forceinline__ unsigned xb_add(unsigned* p, unsigned v) { return __hip_atomic_fetch_add(p, v, __ATOMIC_RELAXED, __HIP_MEMORY_SCOPE_AGENT); }
__device__ __forceinline__ unsigned xb_xcc_id() { return (unsigned)__builtin_amdgcn_s_getreg((3 << 11) | 20) & 0xFu; }
#define XB_SPIN(cond, bar) do { unsigned _sp = 0; while (cond) { __builtin_amdgcn_s_sleep(1); \
    if ((++_sp & 255u) == 0u) { if (xb_ld(&(bar)[XB_TMO])) break; if (_sp > XB_SPIN_CAP) { atomicAdd(&(bar)[XB_TMO], 1u); break; } } } } while (0)
struct XcdBarrier { unsigned* bar; unsigned x; volatile LAS unsigned* st; };
__device__ __forceinline__ XcdBarrier xcd_barrier_post(unsigned* bar, volatile LAS unsigned* st) {
    XcdBarrier b; b.bar = bar; b.x = xb_xcc_id(); b.st = st;
    if (threadIdx.x == 0) (void)xb_add(&bar[XB_XCNT(b.x)], 1u);
    return b;
}
__device__ __forceinline__ void xcd_barrier_complete(unsigned* bar, unsigned x, unsigned& nloc, unsigned& nx) {
    const unsigned G = gridDim.x * gridDim.y * gridDim.z;
    unsigned sum, cnt, mine, sp = 0u;
    for (;;) {
        sum = 0u; cnt = 0u; mine = 0u;
#pragma unroll
        for (unsigned j = 0; j < 16; ++j) { const unsigned c = xb_ld(&bar[XB_XCNT(j)]); sum += c; cnt += (c > 0u) ? 1u : 0u; mine = (j == x) ? c : mine; }
        if (sum == G) break;
        __builtin_amdgcn_s_sleep(1);
        if ((++sp & 255u) == 0u) { if (xb_ld(&bar[XB_TMO])) break; if (sp > XB_SPIN_CAP) { atomicAdd(&bar[XB_TMO], 1u); break; } }
    }
    nloc = mine > 0u ? mine : 1u; nx = cnt > 0u ? cnt : 1u;
}
__device__ __forceinline__ void xcd_barrier(const XcdBarrier& b) {
    asm volatile("s_waitcnt vmcnt(0)" ::: "memory");
    __syncthreads();
    if (threadIdx.x == 0) {
        unsigned* bar = b.bar;
        __builtin_amdgcn_s_waitcnt(0);
        unsigned nloc = b.st[0], nx = b.st[1];
        if (nloc == 0u) { xcd_barrier_complete(bar, b.x, nloc, nx); b.st[0] = nloc; b.st[1] = nx; }
        const unsigned old = xb_add(&bar[XB_XSUB(b.x)], 1u);
        const unsigned gen = old / nloc;
        if (old + 1u == (gen + 1u) * nloc) {
            __builtin_amdgcn_fence(__ATOMIC_RELEASE, "agent");
            asm volatile("s_waitcnt vmcnt(0)" ::: "memory");
            const unsigned og = xb_add(&bar[XB_TOP], 1u);
            const unsigned tg = og / nx;
            if (og + 1u == (tg + 1u) * nx) xb_add(&bar[XB_TOPGEN], 1u);
            else XB_SPIN(xb_ld(&bar[XB_TOPGEN]) == tg, bar);
            __builtin_amdgcn_fence(__ATOMIC_ACQUIRE, "agent");
            xb_add(&bar[XB_XGEN(b.x)], 1u);
            asm volatile("s_waitcnt vmcnt(0)" ::: "memory");
        } else {
            XB_SPIN(xb_ld(&bar[XB_XGEN(b.x)]) == gen, bar);
            __builtin_amdgcn_fence(__ATOMIC_ACQUIRE, "agent");
            asm volatile("s_waitcnt vmcnt(0)" ::: "memory");
        }
    }
    __syncthreads();
}

#ifndef DUP
#define DUP 0
#endif
constexpr int LDS_BYTES = 131072 + 4096 + 8192;
__global__ void __launch_bounds__(512, 2) fwd_megakernel(Params p) {
    extern __shared__ __attribute__((aligned(16))) unsigned char lds_raw[];
    LAS unsigned char* lds = (LAS unsigned char*)lds_raw;
    cg::grid_group grid = cg::this_grid();
    const int G = gridDim.x;
    bf16_t* RA = (bf16_t*)(p.ws + WS_RA); bf16_t* RB = (bf16_t*)(p.ws + WS_RB);
    volatile LAS unsigned* xst = (volatile LAS unsigned*)(lds + 131072 + 2048);
    if (threadIdx.x < 4) xst[threadIdx.x] = 0u;
    __syncthreads();
    const XcdBarrier xbar = xcd_barrier_post((unsigned*)(p.ws + WS_CTL) + 1024, xst);
    p0_prologue(p, lds, G);
    if (DUP == 1) { __syncthreads(); p0_prologue(p, lds, G); }
    if (p.ws == nullptr) grid.sync();
    xcd_barrier(xbar);
    {
        pg8::Gemm g{RA, (const bf16_t*)(p.ws + WS_W1T), MT, N1, DM}; pg8::OrderG1 S; S.init(G, (int)blockIdx.x, (unsigned*)(p.ws + WS_CTL) + 11264);
        EpiG1 E{RB, (f32x2*)(p.ws + WS_LNP), (LAS f32x2*)(lds + 131072 + 4096)};
        pg8::gemm_phase<EpiG1, pg8::OrderG1>(lds, g, S, E);
    }
    mix_phase(p, lds, G, false);
    xcd_barrier(xbar);
    {
        unsigned* cnt = (unsigned*)(p.ws + WS_CTL) + 5120;
        {
            pg8::Gemm g{RB, (const bf16_t*)(p.ws + WS_W2T), MT, DM, GW}; pg8::OrderG2 S; S.init(G, (int)blockIdx.x, cnt);
            EpiRes<true> E{p.xp, p.xs, p.out, RA, (float*)(p.ws + WS_SS1)};
            pg8::gemm_phase<EpiRes<true>, pg8::OrderG2>(lds, g, S, E);
        }
        {
            pg8::Gemm g{RA, (const bf16_t*)(p.ws + WS_W3T), MT, N3, DM}; pg8::OrderG3 S; S.init(G, (int)blockIdx.x, cnt);
            EpiG3 E{RB + 2 * SZ_D, (const float*)(p.ws + WS_SS1), p.out};
            pg8::gemm_phase<EpiG3, pg8::OrderG3>(lds, g, S, E);
        }
    }
    xcd_barrier(xbar);
    if (!(G == 256 && blockIdx.x < 8)) attn_phase(p, lds, 0);
    if (G == 256) {
        pg8::Gemm g{RB, (const bf16_t*)(p.ws + WS_W4T), MT, DM, DM}; pg8::OrderG4 S; S.init(G, (int)blockIdx.x, (unsigned*)(p.ws + WS_CTL) + 8192);
        EpiFinal E{p.out, (float*)(p.ws + WS_SS2), p.fng, (unsigned*)(p.ws + WS_CTL) + 14336};
        pg8::gemm_phase<EpiFinal, pg8::OrderG4>(lds, g, S, E);
        return;
    }
    {
        pg8::Gemm g{RB, (const bf16_t*)(p.ws + WS_W4T), MT, DM, DM}; pg8::OrderG4 S; S.init(G, (int)blockIdx.x, (unsigned*)(p.ws + WS_CTL) + 8192);
        EpiRes<false> E{nullptr, nullptr, p.out, nullptr, (float*)(p.ws + WS_SS2)};
        pg8::gemm_phase<EpiRes<false>, pg8::OrderG4>(lds, g, S, E);
    }
    xcd_barrier(xbar);
    final_phase(p, G);
}

extern "C" void kernel_launch(void* const* d_in, const int* in_sizes, int n_in, void* d_out, int out_size, void* d_ws, size_t ws_size, hipStream_t stream) {
    static int grid_blocks = 0;
    if (!grid_blocks) {
        int dev = 0, cus = 0, per_cu = 0;
        (void)hipGetDevice(&dev);
        (void)hipDeviceGetAttribute(&cus, hipDeviceAttributeMultiprocessorCount, dev);
        (void)hipFuncSetAttribute((const void*)fwd_megakernel, hipFuncAttributeMaxDynamicSharedMemorySize, LDS_BYTES);
        (void)hipOccupancyMaxActiveBlocksPerMultiprocessor(&per_cu, (const void*)fwd_megakernel, 512, LDS_BYTES);
        if (per_cu < 1) per_cu = 1;
        grid_blocks = cus * per_cu;
        if (ws_size < 348 * MiB) fprintf(stderr, "kernel_launch: workspace too small: %zu\n", ws_size);
    }
    (void)hipMemsetAsync((char*)d_ws + WS_CTL, 0, 131072, stream);
    Params p{};
    p.xp = (const float*)d_in[0]; p.xs = (const float*)d_in[1]; p.ck = (const float*)d_in[2]; p.cv = (const float*)d_in[3]; p.norm_g = (const float*)d_in[4]; p.fng = (const float*)d_in[5];
    p.w1 = (const float*)d_in[6]; p.lng = (const float*)d_in[7]; p.lnb = (const float*)d_in[8]; p.wsp = (const float*)d_in[9]; p.bsp = (const float*)d_in[10]; p.w2 = (const float*)d_in[11];
    p.w3 = (const float*)d_in[12]; p.w4 = (const float*)d_in[13]; p.out = (float*)d_out; p.ws = (unsigned char*)d_ws;
    void* args[] = {&p};
    hipError_t e = hipLaunchCooperativeKernel((void*)fwd_megakernel, dim3(grid_blocks), dim3(512), args, LDS_BYTES, stream);
    if (e != hipSuccess) fprintf(stderr, "cooperative launch failed: %s (grid %d)\n", hipGetErrorString(e), grid_blocks);
}
```

```cpp
#include <hip/hip_runtime.h>
#include <hip/hip_cooperative_groups.h>
#include <cstdio>
#include <cstdint>
namespace cg = cooperative_groups;

#define LAS __attribute__((address_space(3)))
typedef unsigned short bf16_t;
typedef short bf16x8 __attribute__((ext_vector_type(8)));
typedef short s16x4 __attribute__((ext_vector_type(4)));
typedef float f32x4 __attribute__((ext_vector_type(4)));
typedef float f32x2 __attribute__((ext_vector_type(2)));
typedef unsigned u32x4 __attribute__((ext_vector_type(4)));
typedef unsigned u32x2 __attribute__((ext_vector_type(2)));

constexpr int DM = 2048, MP = 8192, MS = 256, MT = MP + MS;
constexpr int GW = 4096, N1 = 3 * GW, N3 = 4 * DM;
constexpr size_t MiB = 1u << 20;
constexpr size_t WS_CTL = 0;
constexpr size_t WS_W1T = 4 * MiB, WS_W2T = 52 * MiB, WS_W3T = 68 * MiB, WS_W4T = 100 * MiB;
constexpr size_t WS_RA = 108 * MiB;
constexpr size_t WS_RB = 141 * MiB;
constexpr size_t WS_LNP = 339 * MiB;
constexpr size_t WS_SS1 = 344 * MiB;
constexpr size_t WS_SS2 = 346 * MiB;
constexpr size_t SZ_G = (size_t)MT * GW;
constexpr size_t SZ_D = (size_t)MT * DM;
constexpr size_t O_YP = 0, O_YS = (size_t)MP * DM, O_KP = O_YS + (size_t)MS * DM, O_VP = O_KP + (size_t)MP * DM, O_KS = O_VP + (size_t)MP * DM, O_VS = O_KS + (size_t)MS * DM, O_GMV = O_VS + (size_t)MS * DM;

struct Params {
    const float* xp; const float* xs; const float* ck; const float* cv; const float* norm_g; const float* fng;
    const float* w1; const float* lng; const float* lnb; const float* wsp; const float* bsp; const float* w2; const float* w3; const float* w4;
    float* out; unsigned char* ws;
};

__device__ __forceinline__ unsigned cvt_pk_bf16(float lo, float hi) { unsigned r; asm volatile("v_cvt_pk_bf16_f32 %0, %1, %2" : "=v"(r) : "v"(lo), "v"(hi)); return r; }
__device__ __forceinline__ void st_wt16(void* ptr, u32x4 v) { asm volatile("global_store_dwordx4 %0, %1, off sc1\n\ts_nop 1" :: "v"(ptr), "v"(v) : "memory"); }
__device__ __forceinline__ void st_wt8(void* ptr, u32x2 v) { asm volatile("global_store_dwordx2 %0, %1, off sc1" :: "v"(ptr), "v"(v) : "memory"); }
__device__ __forceinline__ void st_wt4(void* ptr, unsigned v) { asm volatile("global_store_dword %0, %1, off sc1" :: "v"(ptr), "v"(v) : "memory"); }
__device__ __forceinline__ float bf_lo(unsigned w) { return __uint_as_float(w << 16); }
__device__ __forceinline__ float bf_hi(unsigned w) { return __uint_as_float(w & 0xffff0000u); }
__device__ __forceinline__ float fast_sigmoid_mul(float x, float arg) { return x * __builtin_amdgcn_rcpf(1.0f + __builtin_amdgcn_exp2f(-1.4426950408889634f * arg)); }
__device__ __forceinline__ float gelu_tanh(float x) { return fast_sigmoid_mul(x, x * (1.5957691216057308f + 0.07135481627260025f * x * x)); }
__device__ __forceinline__ float silu(float x) { return fast_sigmoid_mul(x, x); }
__device__ __forceinline__ f32x2 exp2_2(f32x2 a) { f32x2 r; r.x = __builtin_amdgcn_exp2f(a.x); r.y = __builtin_amdgcn_exp2f(a.y); return r; }
__device__ __forceinline__ f32x2 rcp_2(f32x2 a) { f32x2 r; r.x = __builtin_amdgcn_rcpf(a.x); r.y = __builtin_amdgcn_rcpf(a.y); return r; }
__device__ __forceinline__ f32x2 gelu_den2(f32x2 x) { return exp2_2(x * ((x * x) * (-0.10294324f) + (-2.3022082f))) + 1.0f; }
__device__ __forceinline__ f32x2 silu_den2(f32x2 x) { return exp2_2(x * (-1.4426950408889634f)) + 1.0f; }
__device__ __forceinline__ f32x2 gelu2(f32x2 x) { return x * rcp_2(gelu_den2(x)); }
__device__ __forceinline__ f32x2 silu2(f32x2 x) { return x * rcp_2(silu_den2(x)); }
__device__ __forceinline__ f32x2 guz2(f32x2 u, f32x2 z) { return (u * z) * rcp_2(gelu_den2(u) * silu_den2(z)); }
__device__ __forceinline__ float wave_sum(float v) {
#pragma unroll
    for (int o = 1; o < 64; o <<= 1) v += __shfl_xor(v, o);
    return v;
}

namespace pg8 {
constexpr int BM = 256, BK = 64, HALF = 128, HTB = HALF * BK * 2, STAGE_BYTES = 8 * HTB, NXCD = 8, WGM = 8;
__host__ __device__ __forceinline__ int lds_byte(int r, int c) { const int st = (r >> 4) * 2 + (c >> 5), rr = r & 15, cc = c & 31, ob = rr * 64 + cc * 2; return st * 1024 + (ob ^ (((ob >> 9) & 1) << 5)); }
__host__ __device__ __forceinline__ void stage_rc(int b, int& R, int& C) { const int st = b / 1024, sb = b % 1024, swz = sb ^ (((sb >> 9) & 1) << 5); R = (st >> 1) * 16 + swz / 64; C = (st & 1) * 32 + (swz % 64) / 2; }
__host__ __device__ __forceinline__ int perm32(int rho) { const int n = rho >> 4, i = rho & 15; return 8 * (i >> 2) + 4 * n + (i & 3); }
struct Unit { int pm, pn; };
struct Gemm { const bf16_t* A; const bf16_t* Bt; int M, N, K; };
struct StaticOrder {
    static constexpr bool PUBLISH = false; unsigned* cnt = nullptr;
    int nM, nN, nwg, G, c;
    __host__ __device__ void init(int M, int N, int G_, int c_) { nM = M / BM; nN = N / BM; nwg = nM * nN; G = G_; c = c_; }
    __host__ __device__ bool next(int i, Unit& u) const {
        const long L = (long)i * G + c; if (L >= nwg) return false;
        int wgid = (int)L; { const int q = nwg / NXCD, r = nwg % NXCD, xcd = wgid % NXCD, off = wgid / NXCD; wgid = (xcd < r ? xcd * (q + 1) : r * (q + 1) + (xcd - r) * q) + off; }
        const int nig = WGM * nN, gid = wgid / nig, fm = gid * WGM, gsz = (nM - fm) < WGM ? (nM - fm) : WGM;
        u.pm = fm + ((wgid % nig) % gsz); u.pn = (wgid % nig) / gsz; return true;
    }
    __device__ __forceinline__ void a_ready(const Unit&) const {}
    __device__ __forceinline__ void done(const Unit&) const {}
};
__device__ __forceinline__ void panel_publish(unsigned* cnt, int pm) {
    asm volatile("s_waitcnt vmcnt(0)" ::: "memory");
    __builtin_amdgcn_s_barrier();
    if (threadIdx.x < 64) {
        __builtin_amdgcn_fence(__ATOMIC_RELEASE, "agent");
        asm volatile("s_waitcnt vmcnt(0)" ::: "memory");
        if (threadIdx.x == 0) __hip_atomic_fetch_add(cnt + 64 * pm, 1u, __ATOMIC_RELAXED, __HIP_MEMORY_SCOPE_AGENT);
    }
}
__device__ __forceinline__ void panel_publish_wt(unsigned* cnt, int pm) {
    asm volatile("s_waitcnt vmcnt(0)" ::: "memory");
    __builtin_amdgcn_s_barrier();
    if (threadIdx.x == 0) __hip_atomic_fetch_add(cnt + 64 * pm, 1u, __ATOMIC_RELAXED, __HIP_MEMORY_SCOPE_AGENT);
}
__device__ __forceinline__ void panel_wait_wave0(unsigned* cnt, int pm, unsigned need) {
    unsigned polls = 0;
    while ((unsigned)__builtin_amdgcn_readfirstlane(__hip_atomic_load(cnt + 64 * pm, __ATOMIC_RELAXED, __HIP_MEMORY_SCOPE_AGENT)) < need) {
        __builtin_amdgcn_s_sleep(2);
        if (++polls > (1u << 22)) break;
    }
    __builtin_amdgcn_fence(__ATOMIC_ACQUIRE, "agent");
    asm volatile("s_waitcnt vmcnt(0)" ::: "memory");
}
struct OrderG1 {
    static constexpr bool PUBLISH = true;
    StaticOrder P; unsigned* cnt; int G, c;
    __device__ void init(int G_, int c_, unsigned* cnt_) { P.init(8192, 12288, G_, c_); G = G_; c = c_; cnt = cnt_; }
    __device__ bool next(int i, Unit& u) const { const int L = i * G + c; if (L < 1536) return P.next(i, u); if (L < 1584) { u.pm = 32; u.pn = L - 1536; return true; } return false; }
    __device__ __forceinline__ void a_ready(const Unit&) const {}
    __device__ __forceinline__ void done(const Unit& u) const { panel_publish_wt(cnt, u.pm); }
};
struct OrderG2 {
    static constexpr bool PUBLISH = true;
    StaticOrder P; unsigned* cnt; int G, c;
    __device__ void init(int G_, int c_, unsigned* cnt_) { P.init(8192, 2048, G_, c_); G = G_; c = c_; cnt = cnt_; }
    __device__ bool next(int i, Unit& u) const { const int L = i * G + c; if (L < 256) return P.next(i, u); if (L < 264) { u.pm = 32; u.pn = L - 256; return true; } return false; }
    __device__ __forceinline__ void a_ready(const Unit&) const {}
    __device__ __forceinline__ void done(const Unit& u) const { panel_publish_wt(cnt, u.pm); }
};
struct OrderG3 {
    static constexpr bool PUBLISH = false;
    StaticOrder P; unsigned* cnt; int G, c;
    __device__ void init(int G_, int c_, unsigned* cnt_) { P.init(8192, 8192, G_, c_); G = G_; c = c_; cnt = cnt_; }
    __device__ bool next(int i, Unit& u) const {
        if (G == 256) {
            if (i < 3) return P.next(i, u);
            if (i == 3) { if (c < 8) return false; return P.next(3, u); }
            if (i == 4) { if (c >= 8 && c < 16) { StaticOrder Q = P; Q.c = c - 8; return Q.next(3, u); } if (c >= 16 && c < 48) { u.pm = 32; u.pn = c - 16; return true; } }
            return false;
        }
        const int L = i * G + c; if (L < 1024) return P.next(i, u); if (L < 1056) { u.pm = 32; u.pn = L - 1024; return true; } return false;
    }
    __device__ __forceinline__ void a_ready(const Unit& u) const {
        if (threadIdx.x < 64) panel_wait_wave0(cnt, u.pm, 8u);
        asm volatile("" ::: "memory"); __builtin_amdgcn_s_barrier(); asm volatile("" ::: "memory");
    }
    __device__ __forceinline__ void done(const Unit&) const {}
};
struct OrderG4 {
    static constexpr bool PUBLISH = false;
    StaticOrder P; unsigned* cnt; int G, c;
    __device__ void init(int G_, int c_, unsigned* cnt_) { P.init(8192, 2048, G_, c_); G = G_; c = c_; cnt = cnt_; }
    __device__ bool next(int i, Unit& u) const {
        if (G == 256) { if (c < 8) { if (i == 0) { u.pm = 32; u.pn = c; return true; } return i == 1 ? P.next(0, u) : false; } return i == 0 ? P.next(0, u) : false; }
        const int L = i * G + c; if (L < 256) return P.next(i, u); if (L < 264) { u.pm = 32; u.pn = L - 256; return true; } return false;
    }
    __device__ __forceinline__ void a_ready(const Unit& u) const {
        if (threadIdx.x < 64) panel_wait_wave0(cnt, u.pm, u.pm == 32 ? 128u : 16u);
        asm volatile("" ::: "memory"); __builtin_amdgcn_s_barrier(); asm volatile("" ::: "memory");
    }
    __device__ __forceinline__ void done(const Unit&) const {}
};

template <class Epi, class Sched, bool ALIGN_EPI = true>
__device__ __forceinline__ void gemm_phase(LAS unsigned char* lds, const Gemm g, const Sched& S, const Epi& E) {
    int tid_ = threadIdx.x; asm volatile("" : "+v"(tid_)); const int tid = tid_, wid = __builtin_amdgcn_readfirstlane(tid >> 6), lane = tid & 63, wr = wid >> 2, wc = wid & 3, fr = lane & 15, fq = lane >> 4;
    const int K = g.K, nt = K / BK;
    unsigned voffA[2], voffB[2];
#pragma unroll
    for (int i = 0; i < 2; ++i) { int R, C; stage_rc(tid * 16 + i * 8192, R, C); const int Rb = Epi::PERM ? ((R & ~31) + perm32(R & 31)) : R;
        voffA[i] = (unsigned)(R * K + C) * 2u; voffB[i] = (unsigned)(Rb * K + C) * 2u; }
    const size_t kstep = (size_t)(BK * 2);
    const size_t hstep = (size_t)HALF * K * 2;
    const size_t tstep = 2 * hstep;
    const unsigned ldsw = (unsigned)wid * 1024u;
    const int aoff = lds_byte(wr * 64 + fr, fq * 8), boff = lds_byte(wc * 32 + fr, fq * 8);
#define PG8_SA(b, h) (((b) * 2 + (h)) * HTB)
#define PG8_SB(b, h) ((4 + (b) * 2 + (h)) * HTB)
#define PG8_STAGE(bufoff, gbase, voff) do { _Pragma("unroll") for (int _i = 0; _i < 2; ++_i) \
        __builtin_amdgcn_global_load_lds((const unsigned*)((const char*)(gbase) + (voff)[_i]), (LAS unsigned*)(lds + (bufoff) + ldsw + _i * 8192), 16, 0, 0); } while (0)
#define PG8_LDA(dst, b, h) do { _Pragma("unroll") for (int m = 0; m < 4; ++m) _Pragma("unroll") for (int k = 0; k < 2; ++k) dst[m][k] = *(const LAS bf16x8*)(lds + PG8_SA(b, h) + aoff + m * 2048 + k * 1024); } while (0)
#define PG8_LDB(dst, b, h) do { _Pragma("unroll") for (int n = 0; n < 2; ++n) _Pragma("unroll") for (int k = 0; k < 2; ++k) dst[n][k] = *(const LAS bf16x8*)(lds + PG8_SB(b, h) + boff + n * 2048 + k * 1024); } while (0)
#define PG8_MMA(ai, bj, At, Bt) do { __builtin_amdgcn_s_setprio(1); _Pragma("unroll") for (int m = 0; m < 4; ++m) _Pragma("unroll") for (int n = 0; n < 2; ++n) _Pragma("unroll") for (int k = 0; k < 2; ++k) \
        acc[ai][bj][m][n] = __builtin_amdgcn_mfma_f32_16x16x32_bf16(Bt[n][k], At[m][k], acc[ai][bj][m][n], 0, 0, 0); __builtin_amdgcn_s_setprio(0); } while (0)
#define PG8_WAIT_V(n) asm volatile("s_waitcnt vmcnt(" #n ")" ::: "memory")
#define PG8_WAIT_L(n) asm volatile("s_waitcnt lgkmcnt(" #n ")" ::: "memory")
#define PG8_BAR __builtin_amdgcn_s_barrier()
#define PG8_SCHED __builtin_amdgcn_sched_barrier(0)
    Unit cur, nxt; int ui = 0; int pend = -1;
    if (!S.next(0, cur)) return;
    f32x4 acc[2][2][4][2];
#pragma unroll
    for (int a = 0; a < 2; ++a)
#pragma unroll
        for (int b = 0; b < 2; ++b)
#pragma unroll
            for (int m = 0; m < 4; ++m)
#pragma unroll
                for (int n = 0; n < 2; ++n) acc[a][b][m][n] = (f32x4){0.f, 0.f, 0.f, 0.f};
    bf16x8 At[4][2], B0[2][2], B1[2][2];
    const char* cA = (const char*)g.A + (size_t)cur.pm * tstep; const char* cB = (const char*)g.Bt + (size_t)cur.pn * tstep;
    S.a_ready(cur);
    PG8_STAGE(PG8_SB(0, 0), cB, voffB); PG8_STAGE(PG8_SB(0, 1), cB + hstep, voffB); PG8_STAGE(PG8_SA(0, 0), cA, voffA); PG8_STAGE(PG8_SA(0, 1), cA + hstep, voffA);
    if (wr == 1) PG8_BAR;
    PG8_WAIT_V(2); PG8_BAR;
    PG8_STAGE(PG8_SB(1, 0), cB + kstep, voffB); PG8_STAGE(PG8_SA(1, 0), cA + kstep, voffA); PG8_STAGE(PG8_SB(1, 1), cB + hstep + kstep, voffB);
    PG8_WAIT_V(6); PG8_BAR;
    for (;;) {
        const bool has_next = S.next(ui + 1, nxt);
        const char* nA = has_next ? (const char*)g.A + (size_t)nxt.pm * tstep : cA; const char* nB = has_next ? (const char*)g.Bt + (size_t)nxt.pn * tstep : cB;
        for (int t = 0; t < nt; t += 2) {
            const bool last = (t == nt - 2);
            const char* a1 = cA + (size_t)(t + 1) * kstep;
            const char* a2 = last ? nA : cA + (size_t)(t + 2) * kstep; const char* b2 = last ? nB : cB + (size_t)(t + 2) * kstep;
            const char* a3 = a2 + kstep; const char* b3 = b2 + kstep;
            if (last && has_next) S.a_ready(nxt);
            if (Sched::PUBLISH && last && pend >= 0) {
                if (tid == 0) __hip_atomic_fetch_add(S.cnt + 64 * pend, 1u, __ATOMIC_RELAXED, __HIP_MEMORY_SCOPE_AGENT);
                pend = -1;
            }
            PG8_LDB(B0, 0, 0); PG8_LDB(B1, 0, 1); PG8_SCHED; PG8_LDA(At, 0, 0); PG8_STAGE(PG8_SA(1, 1), a1 + hstep, voffA);
            PG8_WAIT_V(8); PG8_WAIT_L(0); PG8_BAR; PG8_MMA(0, 0, At, B0); PG8_MMA(0, 1, At, B1); PG8_BAR; PG8_SCHED;
            PG8_LDA(At, 0, 1); PG8_STAGE(PG8_SB(0, 0), b2, voffB); PG8_STAGE(PG8_SB(0, 1), b2 + hstep, voffB); PG8_STAGE(PG8_SA(0, 0), a2, voffA);
            PG8_WAIT_V(8); PG8_WAIT_L(0); PG8_BAR; PG8_MMA(1, 0, At, B0); PG8_MMA(1, 1, At, B1); PG8_BAR; PG8_SCHED;
            PG8_LDB(B0, 1, 0); PG8_LDB(B1, 1, 1); PG8_SCHED; PG8_LDA(At, 1, 0); PG8_STAGE(PG8_SA(0, 1), a2 + hstep, voffA);
            PG8_WAIT_V(8); PG8_WAIT_L(0); PG8_BAR; PG8_MMA(0, 0, At, B0); PG8_MMA(0, 1, At, B1); PG8_BAR; PG8_SCHED;
            PG8_LDA(At, 1, 1); PG8_STAGE(PG8_SB(1, 0), b3, voffB); PG8_STAGE(PG8_SB(1, 1), b3 + hstep, voffB); PG8_STAGE(PG8_SA(1, 0), a3, voffA);
            PG8_WAIT_V(8); PG8_WAIT_L(0); PG8_BAR; PG8_MMA(1, 0, At, B0); PG8_MMA(1, 1, At, B1); PG8_BAR; PG8_SCHED;
        }
        if constexpr (ALIGN_EPI) { if (wr == 0) PG8_BAR; }
        E(acc, cur, wr, wc, fr, fq); if (Sched::PUBLISH) pend = cur.pm;
        if (!has_next) break;
#pragma unroll
        for (int a = 0; a < 2; ++a)
#pragma unroll
            for (int b = 0; b < 2; ++b)
#pragma unroll
                for (int m = 0; m < 4; ++m)
#pragma unroll
                    for (int n = 0; n < 2; ++n) acc[a][b][m][n] = (f32x4){0.f, 0.f, 0.f, 0.f};
        cur = nxt; cA = nA; cB = nB; ++ui;
        if constexpr (ALIGN_EPI) { if (wr == 1) PG8_BAR; }
    }
    PG8_WAIT_V(0);
    if constexpr (!ALIGN_EPI) { if (wr == 0) PG8_BAR; }
    PG8_BAR;
    if (Sched::PUBLISH && pend >= 0 && tid == 0) __hip_atomic_fetch_add(S.cnt + 64 * pend, 1u, __ATOMIC_RELAXED, __HIP_MEMORY_SCOPE_AGENT);
#undef PG8_SA
#undef PG8_SB
#undef PG8_STAGE
#undef PG8_LDA
#undef PG8_LDB
#undef PG8_MMA
#undef PG8_WAIT_V
#undef PG8_WAIT_L
#undef PG8_BAR
#undef PG8_SCHED
}
}

struct EpiG1 {
    static constexpr bool PERM = true;
    bf16_t* rb; f32x2* lnp; LAS f32x2* red;
    __device__ __forceinline__ void operator()(const f32x4 (&acc)[2][2][4][2], const pg8::Unit& u, int wr, int wc, int fr, int fq) const {
        const int row0 = u.pm * 256 + wr * 64 + fr;
        if (u.pn < 32) {
            const int col0 = u.pn * 128 + wc * 32 + 8 * fq;
#pragma unroll
            for (int ai = 0; ai < 2; ++ai)
#pragma unroll
                for (int m = 0; m < 4; ++m) {
                    const int row = row0 + ai * 128 + m * 16;
                    const f32x4 u0 = acc[ai][0][m][0], u1 = acc[ai][0][m][1], z0 = acc[ai][1][m][0], z1 = acc[ai][1][m][1];
                    const f32x2 a = guz2((f32x2){u0[0], u0[1]}, (f32x2){z0[0], z0[1]}), b = guz2((f32x2){u0[2], u0[3]}, (f32x2){z0[2], z0[3]});
                    const f32x2 c = guz2((f32x2){u1[0], u1[1]}, (f32x2){z1[0], z1[1]}), d = guz2((f32x2){u1[2], u1[3]}, (f32x2){z1[2], z1[3]});
                    u32x4 w; w.x = cvt_pk_bf16(a.x, a.y); w.y = cvt_pk_bf16(b.x, b.y); w.z = cvt_pk_bf16(c.x, c.y); w.w = cvt_pk_bf16(d.x, d.y);
                    st_wt16(rb + (size_t)row * GW + col0, w);
                }
        } else {
            const int pv = u.pn - 32;
            bf16_t* base = rb + SZ_G;
            const int col0 = pv * 256 + wc * 32 + 8 * fq;
#pragma unroll
            for (int ai = 0; ai < 2; ++ai)
#pragma unroll
                for (int m = 0; m < 4; ++m) {
                    const int row = row0 + ai * 128 + m * 16;
                    bf16_t* rowp = base + (size_t)row * GW + col0;
                    f32x2 s2 = (f32x2){0.f, 0.f}, q2 = s2;
#pragma unroll
                    for (int bj = 0; bj < 2; ++bj) {
                        const f32x4 x0 = acc[ai][bj][m][0], x1 = acc[ai][bj][m][1];
                        const f32x2 a = gelu2((f32x2){x0[0], x0[1]}), b = gelu2((f32x2){x0[2], x0[3]}), c = gelu2((f32x2){x1[0], x1[1]}), d = gelu2((f32x2){x1[2], x1[3]});
                        s2 += (a + b) + (c + d); q2 += (a * a + b * b) + (c * c + d * d);
                        u32x4 w; w.x = cvt_pk_bf16(a.x, a.y); w.y = cvt_pk_bf16(b.x, b.y); w.z = cvt_pk_bf16(c.x, c.y); w.w = cvt_pk_bf16(d.x, d.y);
                        st_wt16(rowp + bj * 128, w);
                    }
                    float s = s2.x + s2.y, q = q2.x + q2.y;
                    s += __shfl_xor(s, 16); s += __shfl_xor(s, 32); q += __shfl_xor(q, 16); q += __shfl_xor(q, 32);
                    if (fq == 0) red[(ai * 128 + wr * 64 + m * 16 + fr) * 4 + wc] = (f32x2){s, q};
                }
            asm volatile("s_waitcnt lgkmcnt(0)" ::: "memory"); __builtin_amdgcn_s_barrier(); asm volatile("" ::: "memory");
            if (threadIdx.x < 256) {
                const int r = threadIdx.x; const f32x2 a = red[r * 4 + 0], b = red[r * 4 + 1], c = red[r * 4 + 2], d = red[r * 4 + 3];
                st_wt8(lnp + (size_t)(u.pm * 256 + r) * 16 + pv, (u32x2){__float_as_uint((a[0] + b[0]) + (c[0] + d[0])), __float_as_uint((a[1] + b[1]) + (c[1] + d[1]))});
            }
        }
    }
};
template <bool FIRST> struct EpiRes {
    static constexpr bool PERM = false;
    const float* xp; const float* xs; float* oy; bf16_t* xb; float* ss;
    __device__ __forceinline__ void operator()(const f32x4 (&acc)[2][2][4][2], const pg8::Unit& u, int wr, int wc, int fr, int fq) const {
        const int row0 = u.pm * 256 + wr * 64 + fr, col0 = u.pn * 256 + wc * 32 + 4 * fq;
#pragma unroll
        for (int ai = 0; ai < 2; ++ai)
#pragma unroll
            for (int m = 0; m < 4; ++m) {
                const int row = row0 + ai * 128 + m * 16;
                float* orow = oy + (size_t)row * DM + col0;
                const float* xr = FIRST ? ((row < MP ? xp + (size_t)row * DM : xs + (size_t)(row - MP) * DM) + col0) : orow;
                float q = 0.f;
#pragma unroll
                for (int bj = 0; bj < 2; ++bj)
#pragma unroll
                    for (int n = 0; n < 2; ++n) {
                        const f32x4 xv = *(const f32x4*)(xr + bj * 128 + n * 16);
                        const f32x4 o = xv + acc[ai][bj][m][n];
                        *(f32x4*)(orow + bj * 128 + n * 16) = o;
                        q += (o[0] * o[0] + o[1] * o[1]) + (o[2] * o[2] + o[3] * o[3]);
                        if (FIRST) { u32x2 w; w.x = cvt_pk_bf16(o[0], o[1]); w.y = cvt_pk_bf16(o[2], o[3]); st_wt8(xb + (size_t)row * DM + col0 + bj * 128 + n * 16, w); }
                    }
                q += __shfl_xor(q, 16); q += __shfl_xor(q, 32);
                if (fq == 0) { if (FIRST) st_wt4(ss + (size_t)row * 32 + u.pn * 4 + wc, __float_as_uint(q)); else ss[(size_t)row * 32 + u.pn * 4 + wc] = q; }
            }
    }
};
struct EpiFinal {
    static constexpr bool PERM = false;
    float* oy; float* ss; const float* fng; unsigned* cnt;
    __device__ __forceinline__ void operator()(f32x4 (&acc)[2][2][4][2], const pg8::Unit& u, int wr, int wc, int fr, int fq) const {
        const int row0 = u.pm * 256 + wr * 64 + fr, col0 = u.pn * 256 + wc * 32 + 4 * fq;
#pragma unroll
        for (int ai = 0; ai < 2; ++ai)
#pragma unroll
            for (int m = 0; m < 4; ++m) {
                const int row = row0 + ai * 128 + m * 16;
                const float* xr = oy + (size_t)row * DM + col0;
                float q = 0.f;
#pragma unroll
                for (int bj = 0; bj < 2; ++bj)
#pragma unroll
                    for (int n = 0; n < 2; ++n) {
                        const f32x4 o = *(const f32x4*)(xr + bj * 128 + n * 16) + acc[ai][bj][m][n];
                        acc[ai][bj][m][n] = o;
                        q += (o[0] * o[0] + o[1] * o[1]) + (o[2] * o[2] + o[3] * o[3]);
                    }
                q += __shfl_xor(q, 16); q += __shfl_xor(q, 32);
                if (fq == 0) st_wt4(ss + (size_t)row * 32 + u.pn * 4 + wc, __float_as_uint(q));
            }
        asm volatile("s_waitcnt vmcnt(0)" ::: "memory");
        __builtin_amdgcn_s_barrier();
        if (threadIdx.x < 64) {
            if (threadIdx.x == 0) __hip_atomic_fetch_add(cnt + 64 * u.pm, 1u, __ATOMIC_RELAXED, __HIP_MEMORY_SCOPE_AGENT);
            pg8::panel_wait_wave0(cnt, u.pm, 8u);
        }
        asm volatile("" ::: "memory"); __builtin_amdgcn_s_barrier(); asm volatile("" ::: "memory");
        f32x4 gg[2][2];
#pragma unroll
        for (int bj = 0; bj < 2; ++bj)
#pragma unroll
            for (int n = 0; n < 2; ++n) gg[bj][n] = *(const f32x4*)(fng + col0 + bj * 128 + n * 16);
#pragma unroll
        for (int ai = 0; ai < 2; ++ai)
#pragma unroll
            for (int m = 0; m < 4; ++m) {
                const int row = row0 + ai * 128 + m * 16;
                const f32x4 pa = *(const f32x4*)(ss + (size_t)row * 32 + 8 * fq), pb = *(const f32x4*)(ss + (size_t)row * 32 + 8 * fq + 4);
                float sq = ((pa[0] + pa[1]) + (pa[2] + pa[3])) + ((pb[0] + pb[1]) + (pb[2] + pb[3]));
                sq += __shfl_xor(sq, 16); sq += __shfl_xor(sq, 32);
                const float rinv = __builtin_amdgcn_rsqf(sq * (1.0f / DM) + 1e-6f);
                float* orow = oy + (size_t)row * DM + col0;
#pragma unroll
                for (int bj = 0; bj < 2; ++bj)
#pragma unroll
                    for (int n = 0; n < 2; ++n) *(f32x4*)(orow + bj * 128 + n * 16) = acc[ai][bj][m][n] * rinv * gg[bj][n];
            }
    }
};
struct EpiG3 {
    static constexpr bool PERM = true;
    bf16_t* rb; const float* ss1; float* out;
    __device__ __forceinline__ void operator()(const f32x4 (&acc)[2][2][4][2], const pg8::Unit& u, int wr, int wc, int fr, int fq) const {
        const int t = u.pn >> 3;
        bf16_t* base = rb + (size_t)t * SZ_D;
        const int row0 = u.pm * 256 + wr * 64 + fr, col0 = (u.pn & 7) * 256 + wc * 32 + 8 * fq;
#pragma unroll
        for (int ai = 0; ai < 2; ++ai)
#pragma unroll
            for (int m = 0; m < 4; ++m) {
                const int row = row0 + ai * 128 + m * 16;
                const f32x4 pa = *(const f32x4*)(ss1 + (size_t)row * 32 + 8 * fq), pb = *(const f32x4*)(ss1 + (size_t)row * 32 + 8 * fq + 4);
                float s = ((pa[0] + pa[1]) + (pa[2] + pa[3])) + ((pb[0] + pb[1]) + (pb[2] + pb[3]));
                s += __shfl_xor(s, 16); s += __shfl_xor(s, 32);
                float rinv = __builtin_amdgcn_rsqf(s * (1.0f / DM) + 1e-6f);
                if (t == 0) rinv *= 0.08838834764831845f * 1.4426950408889634f;
                bf16_t* rowp = base + (size_t)row * DM + col0;
                float* fo = nullptr;
                if (t == 1) fo = out + (row < MP ? O_KP + (size_t)row * DM : O_KS + (size_t)(row - MP) * DM) + col0;
                if (t == 2) fo = out + (row < MP ? O_VP + (size_t)row * DM : O_VS + (size_t)(row - MP) * DM) + col0;
#pragma unroll
                for (int bj = 0; bj < 2; ++bj) {
                    f32x4 v0 = acc[ai][bj][m][0] * rinv, v1 = acc[ai][bj][m][1] * rinv;
                    if (t == 3) {
                        const f32x2 a = silu2((f32x2){v0[0], v0[1]}), b = silu2((f32x2){v0[2], v0[3]}), c = silu2((f32x2){v1[0], v1[1]}), d = silu2((f32x2){v1[2], v1[3]});
                        v0 = (f32x4){a.x, a.y, b.x, b.y}; v1 = (f32x4){c.x, c.y, d.x, d.y};
                    }
                    if (t == 1 || t == 2) { *(f32x4*)(fo + bj * 128) = v0; *(f32x4*)(fo + bj * 128 + 4) = v1; }
                    u32x4 w; w.x = cvt_pk_bf16(v0[0], v0[1]); w.y = cvt_pk_bf16(v0[2], v0[3]); w.z = cvt_pk_bf16(v1[0], v1[1]); w.w = cvt_pk_bf16(v1[2], v1[3]);
                    *(u32x4*)(rowp + bj * 128) = w;
                }
            }
    }
};

__device__ __forceinline__ void p0_transpose_item(const float* W, int K, int N, bf16_t* WT, const float* gk, LAS float* scr, int item, int lane, bool w1map) {
    const int nblk = N / 32, kb = item / nblk, nb = item % nblk, k0 = 64 * kb, n0 = 32 * nb;
    int nd0 = n0;
    if (w1map) { if (n0 < GW) nd0 = (n0 >> 7) * 256 + (n0 & 127); else if (n0 < 2 * GW) nd0 = 2 * GW + (n0 - GW); else { const int c = n0 - 2 * GW; nd0 = (c >> 7) * 256 + 128 + (c & 127); } }
    float wv[32];
#pragma unroll
    for (int i = 0; i < 32; ++i) wv[i] = W[(size_t)(k0 + 2 * i + (lane >> 5)) * N + n0 + (lane & 31)];
    if (gk) {
#pragma unroll
        for (int i = 0; i < 32; ++i) wv[i] *= gk[k0 + 2 * i + (lane >> 5)];
    }
#pragma unroll
    for (int i = 0; i < 32; ++i) scr[(2 * i + (lane >> 5)) * 33 + (lane & 31)] = wv[i];
    asm volatile("s_waitcnt lgkmcnt(0)" ::: "memory");
    const int c = lane & 7;
#pragma unroll
    for (int j = 0; j < 4; ++j) { const int n = (lane >> 3) + 8 * j; const LAS float* s = scr + (8 * c) * 33 + n;
        u32x4 o; o.x = cvt_pk_bf16(s[0 * 33], s[1 * 33]); o.y = cvt_pk_bf16(s[2 * 33], s[3 * 33]); o.z = cvt_pk_bf16(s[4 * 33], s[5 * 33]); o.w = cvt_pk_bf16(s[6 * 33], s[7 * 33]);
        *(u32x4*)(WT + (size_t)(nd0 + n) * K + k0 + 8 * c) = o; }
    asm volatile("s_waitcnt lgkmcnt(0)" ::: "memory");
}
__device__ __forceinline__ void p0_prologue(const Params& p, LAS unsigned char* lds, int G) {
    int tid_ = threadIdx.x; asm volatile("" : "+v"(tid_)); const int tid = tid_, lane = tid & 63, wave = tid >> 6;
    LAS float* scr = (LAS float*)(lds + wave * 16384);
    const int gw = blockIdx.x * 8 + wave, NGW = G * 8;
    bf16_t* W1T = (bf16_t*)(p.ws + WS_W1T); bf16_t* W2T = (bf16_t*)(p.ws + WS_W2T); bf16_t* W3T = (bf16_t*)(p.ws + WS_W3T); bf16_t* W4T = (bf16_t*)(p.ws + WS_W4T);
    constexpr int I1 = (DM / 64) * (N1 / 32), I2 = (GW / 64) * (DM / 32), I3 = (DM / 64) * (N3 / 32), I4 = (DM / 64) * (DM / 32);
    bf16_t* h0 = (bf16_t*)(p.ws + WS_RA);
    for (int m = gw; m < MT; m += NGW) {
        const float* xrow = (m < MP) ? p.xp + (size_t)m * DM : p.xs + (size_t)(m - MP) * DM;
        f32x4 v[8]; float s = 0.f;
#pragma unroll
        for (int j = 0; j < 8; ++j) { v[j] = *(const f32x4*)(xrow + 4 * lane + 256 * j); s += (v[j][0] * v[j][0] + v[j][1] * v[j][1]) + (v[j][2] * v[j][2] + v[j][3] * v[j][3]); }
        const float rinv = __builtin_amdgcn_rsqf(wave_sum(s) * (1.0f / DM) + 1e-6f);
#pragma unroll
        for (int j = 0; j < 8; ++j) { const f32x4 gg = *(const f32x4*)(p.norm_g + 4 * lane + 256 * j);
            u32x2 w; w.x = cvt_pk_bf16(v[j][0] * rinv * gg[0], v[j][1] * rinv * gg[1]); w.y = cvt_pk_bf16(v[j][2] * rinv * gg[2], v[j][3] * rinv * gg[3]);
            *(u32x2*)(h0 + (size_t)m * DM + 4 * lane + 256 * j) = w; }
    }
    for (int it = gw; it < I1 + I2 + I3 + I4; it += NGW) {
        int r = it;
        if (r < I1) { p0_transpose_item(p.w1, DM, N1, W1T, nullptr, scr, r, lane, true); continue; } r -= I1;
        if (r < I2) { p0_transpose_item(p.w2, GW, DM, W2T, nullptr, scr, r, lane, false); continue; } r -= I2;
        if (r < I3) { p0_transpose_item(p.w3, DM, N3, W3T, p.norm_g + DM, scr, r, lane, false); continue; } r -= I3;
        p0_transpose_item(p.w4, DM, DM, W4T, nullptr, scr, r, lane, false);
    }
}

constexpr int MIX_WP = 136, MIX_VP = 264;
constexpr int MIX_W_OFF = 0, MIX_V_OFF = 128 * MIX_WP * 2, MIX_ST_OFF = MIX_V_OFF + 128 * MIX_VP * 2;
__device__ __forceinline__ void mix_phase(const Params& p, LAS unsigned char* lds, int G, bool dry) {
    int tid_ = threadIdx.x; asm volatile("" : "+v"(tid_)); const int tid = tid_, wid = tid >> 6, lane = tid & 63, wr = wid >> 2, wc = wid & 3, fr = lane & 15, fq = lane >> 4;
    bf16_t* gu = (bf16_t*)(p.ws + WS_RB); const bf16_t* gv = gu + SZ_G;
    const f32x2* lnp = (const f32x2*)(p.ws + WS_LNP);
    LAS bf16_t* Wl = (LAS bf16_t*)(lds + MIX_W_OFF); LAS bf16_t* Vl = (LAS bf16_t*)(lds + MIX_V_OFF); LAS float* st = (LAS float*)(lds + MIX_ST_OFF);
    unsigned* ctr = (unsigned*)(p.ws + WS_CTL) + 2; unsigned* pcnt = (unsigned*)(p.ws + WS_CTL) + 11264;
    volatile LAS int* misc = (volatile LAS int*)(lds + MIX_ST_OFF + 1024);
    unsigned long long seen = 0ull;
    if (tid == 0) misc[0] = (int)atomicAdd(ctr, 1u);
    for (;;) {
        __syncthreads();
        const int unit = misc[0];
        if (unit >= 66 * 16) break;
        const int nb = unit >> 4, g = unit & 15, row_base = nb * 128; const bool smp = nb >= 64;
        if (!((seen >> (nb >> 1)) & 1ull)) {
            if (tid < 64) pg8::panel_wait_wave0(pcnt, nb >> 1, 48u);
            seen |= 1ull << (nb >> 1);
        }
        __syncthreads();
        int nticket = 0;
        if (tid == 0) nticket = (int)atomicAdd(ctr, 1u);
        u32x4 raw[8];
#pragma unroll
        for (int i = 0; i < 8; ++i) { const int cid = tid + 512 * i, s = cid >> 5, c = (cid & 31) * 8; raw[i] = *(const u32x4*)(gv + (size_t)(row_base + s) * GW + g * 256 + c); }
        const int t = tid >> 2, s0 = (tid & 3) * 32; bool on; const float* src;
        if (smp) { on = (t >> 5) == (tid & 3); src = p.wsp + ((size_t)g * 128 + (t & 31)) * 128; }
        else { on = (s0 >> 6) <= (t >> 6); src = p.wsp + ((size_t)g * 128 + t) * 128 + s0; }
        f32x4 wa[8];
#pragma unroll
        for (int j = 0; j < 8; ++j) wa[j] = on ? *(const f32x4*)(src + 4 * j) : (f32x4){0.f, 0.f, 0.f, 0.f};
        float ssum = 0.f, qsum = 0.f;
        {   const f32x4* pp = (const f32x4*)(lnp + (size_t)(row_base + t) * 16) + (tid & 3) * 2;
#pragma unroll
            for (int i = 0; i < 2; ++i) { const f32x4 a = pp[i]; ssum += a[0] + a[2]; qsum += a[1] + a[3]; } }
        const int cc = g * 256 + (tid & 31) * 8;
        const f32x4 g0 = *(const f32x4*)(p.lng + cc), g1 = *(const f32x4*)(p.lng + cc + 4), b0 = *(const f32x4*)(p.lnb + cc), b1 = *(const f32x4*)(p.lnb + cc + 4);
        ssum += __shfl_xor(ssum, 1); qsum += __shfl_xor(qsum, 1); ssum += __shfl_xor(ssum, 2); qsum += __shfl_xor(qsum, 2);
        if ((tid & 3) == 0) { const float mean = ssum * (1.0f / GW), var = qsum * (1.0f / GW) - mean * mean; st[t] = mean; st[128 + t] = __builtin_amdgcn_rsqf(var + 1e-5f); }
#pragma unroll
        for (int j = 0; j < 4; ++j) { const f32x4 a = wa[2 * j], b2 = wa[2 * j + 1];
            u32x4 w; w.x = cvt_pk_bf16(a[0], a[1]); w.y = cvt_pk_bf16(a[2], a[3]); w.z = cvt_pk_bf16(b2[0], b2[1]); w.w = cvt_pk_bf16(b2[2], b2[3]);
            *(LAS u32x4*)(Wl + t * MIX_WP + s0 + 8 * j) = w; }
        __syncthreads();
#pragma unroll
        for (int i = 0; i < 8; ++i) {
            const int cid = tid + 512 * i, s = cid >> 5, c = (cid & 31) * 8;
            const float mu = st[s], rs = st[128 + s];
            f32x4 x0 = (f32x4){bf_lo(raw[i].x), bf_hi(raw[i].x), bf_lo(raw[i].y), bf_hi(raw[i].y)}, x1 = (f32x4){bf_lo(raw[i].z), bf_hi(raw[i].z), bf_lo(raw[i].w), bf_hi(raw[i].w)};
            x0 = (x0 - mu) * rs * g0 + b0; x1 = (x1 - mu) * rs * g1 + b1;
            if (smp) { float* o = p.out + O_GMV + (size_t)(row_base - MP + s) * GW + g * 256 + c; *(f32x4*)o = x0; *(f32x4*)(o + 4) = x1; }
            u32x4 w; w.x = cvt_pk_bf16(x0[0], x0[1]); w.y = cvt_pk_bf16(x0[2], x0[3]); w.z = cvt_pk_bf16(x1[0], x1[1]); w.w = cvt_pk_bf16(x1[2], x1[3]);
            *(LAS u32x4*)(Vl + s * MIX_VP + c) = w;
        }
        u32x2 ur[4][4]; float bias[4];
        bf16_t* const gup = gu + (size_t)(row_base + 64 * wr + fr) * GW + g * 256 + 64 * wc + 4 * fq;
#pragma unroll
        for (int m = 0; m < 4; ++m) {
            const int tt = 64 * wr + 16 * m + fr; bias[m] = p.bsp[g * 128 + (smp ? (tt & 31) : tt)];
#pragma unroll
            for (int n = 0; n < 4; ++n) ur[m][n] = *(const u32x2*)(gup + (size_t)m * 16 * GW + 16 * n);
        }
        __syncthreads();
        f32x4 acc[4][4];
#pragma unroll
        for (int m = 0; m < 4; ++m)
#pragma unroll
            for (int n = 0; n < 4; ++n) acc[m][n] = (f32x4){0.f, 0.f, 0.f, 0.f};
#pragma unroll
        for (int ks = 0; ks < 4; ++ks) {
            bf16x8 af[4], bfr[4];
#pragma unroll
            for (int m = 0; m < 4; ++m) af[m] = *(const LAS bf16x8*)(Wl + (64 * wr + 16 * m + fr) * MIX_WP + 32 * ks + 8 * fq);
#pragma unroll
            for (int n = 0; n < 4; ++n) {
                const LAS bf16_t* a0 = Vl + (32 * ks + 8 * fq + (fr >> 2)) * MIX_VP + 64 * wc + 16 * n + 4 * (fr & 3);
                const s16x4 lo = __builtin_amdgcn_ds_read_tr16_b64_v4i16((LAS s16x4*)a0), hi = __builtin_amdgcn_ds_read_tr16_b64_v4i16((LAS s16x4*)(a0 + 4 * MIX_VP));
                bfr[n] = (bf16x8){lo[0], lo[1], lo[2], lo[3], hi[0], hi[1], hi[2], hi[3]};
            }
#pragma unroll
            for (int m = 0; m < 4; ++m)
#pragma unroll
                for (int n = 0; n < 4; ++n) acc[m][n] = __builtin_amdgcn_mfma_f32_16x16x32_bf16(bfr[n], af[m], acc[m][n], 0, 0, 0);
        }
#pragma unroll
        for (int m = 0; m < 4; ++m) {
#pragma unroll
            for (int n = 0; n < 4; ++n) {
                const f32x4 a = acc[m][n] + bias[m]; const u32x2 u2 = ur[m][n];
                u32x2 w; w.x = cvt_pk_bf16(bf_lo(u2.x) * a[0], bf_hi(u2.x) * a[1]); w.y = cvt_pk_bf16(bf_lo(u2.y) * a[2], bf_hi(u2.y) * a[3]);
                if (!dry) *(u32x2*)(gup + (size_t)m * 16 * GW + 16 * n) = w;
            }
        }
        if (tid == 0) misc[0] = nticket;
    }
}

constexpr int AT_P = 136;
constexpr int AT_K_OFF = 0, AT_V_OFF = 64 * AT_P * 2, AT_MISC_OFF = 2 * 64 * AT_P * 2;
constexpr int AT_ITEMS = 512 + 128;
__device__ __forceinline__ void attn_phase(const Params& p, LAS unsigned char* lds, int cidx) {
    int tid_ = threadIdx.x; asm volatile("" : "+v"(tid_)); const int tid = tid_, wid = __builtin_amdgcn_readfirstlane(tid >> 6), lane = tid & 63, fr = lane & 15, fq = lane >> 4;
    const bf16_t* qb = (const bf16_t*)(p.ws + WS_RB) + 2 * SZ_D; const bf16_t* kb = qb + SZ_D; const bf16_t* vb = qb + 2 * SZ_D; const bf16_t* sz1 = qb + 3 * SZ_D; bf16_t* y1 = (bf16_t*)(p.ws + WS_RB);
    unsigned* ctr = (unsigned*)(p.ws + WS_CTL) + cidx; unsigned* pcnt = (unsigned*)(p.ws + WS_CTL) + 8192;
    LAS bf16_t* Kl = (LAS bf16_t*)(lds + AT_K_OFF); LAS bf16_t* Vl = (LAS bf16_t*)(lds + AT_V_OFF); volatile LAS int* misc = (volatile LAS int*)(lds + AT_MISC_OFF);
    int prev_pm = -1, cur_pm = -1;
    for (;;) {
        __syncthreads();
        if (tid == 0) misc[0] = (int)atomicAdd(ctr, 1u);
        __syncthreads();
        const int item = misc[0];
        if (item >= AT_ITEMS) break;
        prev_pm = cur_pm;
        const bool smp = item < 128;
        int b, h, x, kt_hi, qrow0, tpos0; size_t krow0;
        if (!smp) { const int it = item - 128; x = it >> 6; const int bh = it & 63; b = bh >> 4; h = bh & 15; kt_hi = 4 * x + 3; qrow0 = b * 2048 + x * 256 + 32 * wid; tpos0 = x * 256 + 32 * wid; krow0 = (size_t)b * 2048; cur_pm = b * 8 + x; }
        else { x = 0; const int bh = item; b = bh >> 4; h = bh & 15; kt_hi = 16; qrow0 = MP + b * 32; tpos0 = 1024; krow0 = 0; cur_pm = 32; }
        const bool active = !smp || wid == 0;
        bf16x8 qf[2][4];
#pragma unroll
        for (int mt = 0; mt < 2; ++mt)
#pragma unroll
            for (int kk = 0; kk < 4; ++kk) qf[mt][kk] = *(const bf16x8*)(qb + (size_t)(qrow0 + 16 * mt + fr) * DM + h * 128 + 32 * kk + 8 * fq);
        f32x4 o[2][8];
#pragma unroll
        for (int mt = 0; mt < 2; ++mt)
#pragma unroll
            for (int dt = 0; dt < 8; ++dt) o[mt][dt] = (f32x4){0.f, 0.f, 0.f, 0.f};
        float C[2] = {0.f, 0.f};
        bool wdone = !active;
        if (lane == 0) misc[8 + wid] = wdone ? 1 : 0;
        f32x4 pf[2][4];
        if (!smp) {
#pragma unroll
            for (int i = 0; i < 2; ++i) { const int cid = tid + 512 * i, key = cid >> 4, d8 = (cid & 15) * 8; const size_t off = (krow0 + kt_hi * 64 + key) * DM + h * 128 + d8;
                pf[i][0] = __builtin_bit_cast(f32x4, *(const u32x4*)(kb + off)); pf[i][2] = __builtin_bit_cast(f32x4, *(const u32x4*)(vb + off)); }
        }
        for (int kt = kt_hi; kt >= 0; --kt) {
            __syncthreads();
            {
                int alld = 1;
#pragma unroll
                for (int w = 0; w < 8; ++w) alld &= misc[8 + w];
                if (alld) break;
            }
#pragma unroll
            for (int i = 0; i < 2; ++i) {
                const int cid = tid + 512 * i, key = cid >> 4, d8 = (cid & 15) * 8;
                u32x4 kwv, vwv;
                if (!smp) { kwv = __builtin_bit_cast(u32x4, pf[i][0]); vwv = __builtin_bit_cast(u32x4, pf[i][2]); }
                else if (kt == 16) {
                    if (key < 32) { const size_t off = (size_t)(MP + b * 32 + key) * DM + h * 128 + d8; kwv = *(const u32x4*)(kb + off); vwv = *(const u32x4*)(vb + off); }
                    else { kwv = (u32x4){0u, 0u, 0u, 0u}; vwv = kwv; }
                } else {
                    const f32x4 k0 = pf[i][0], k1 = pf[i][1], v0 = pf[i][2], v1 = pf[i][3];
                    kwv.x = cvt_pk_bf16(k0[0], k0[1]); kwv.y = cvt_pk_bf16(k0[2], k0[3]); kwv.z = cvt_pk_bf16(k1[0], k1[1]); kwv.w = cvt_pk_bf16(k1[2], k1[3]);
                    vwv.x = cvt_pk_bf16(v0[0], v0[1]); vwv.y = cvt_pk_bf16(v0[2], v0[3]); vwv.z = cvt_pk_bf16(v1[0], v1[1]); vwv.w = cvt_pk_bf16(v1[2], v1[3]);
                }
                *(LAS u32x4*)(Kl + key * AT_P + d8) = kwv; *(LAS u32x4*)(Vl + key * AT_P + d8) = vwv;
            }
            if (kt > 0) {
#pragma unroll
                for (int i = 0; i < 2; ++i) {
                    const int cid = tid + 512 * i, key = cid >> 4, d8 = (cid & 15) * 8;
                    if (!smp) { const size_t off = (krow0 + (kt - 1) * 64 + key) * DM + h * 128 + d8; pf[i][0] = __builtin_bit_cast(f32x4, *(const u32x4*)(kb + off)); pf[i][2] = __builtin_bit_cast(f32x4, *(const u32x4*)(vb + off)); }
                    else { const size_t off = (((size_t)b * 1024 + (kt - 1) * 64 + key) * 16 + h) * 128 + d8;
                        pf[i][0] = *(const f32x4*)(p.ck + off); pf[i][1] = *(const f32x4*)(p.ck + off + 4); pf[i][2] = *(const f32x4*)(p.cv + off); pf[i][3] = *(const f32x4*)(p.cv + off + 4); }
                }
            }
            __syncthreads();
            if (!wdone && kt * 64 < tpos0 + 31) {
                f32x4 st[2][4];
#pragma unroll
                for (int mt = 0; mt < 2; ++mt)
#pragma unroll
                    for (int n = 0; n < 4; ++n) st[mt][n] = (f32x4){0.f, 0.f, 0.f, 0.f};
#pragma unroll
                for (int kk = 0; kk < 4; ++kk)
#pragma unroll
                    for (int n = 0; n < 4; ++n) {
                        const bf16x8 kf = *(const LAS bf16x8*)(Kl + (16 * (fr >> 2) + 4 * n + (fr & 3)) * AT_P + 32 * kk + 8 * fq);
                        st[0][n] = __builtin_amdgcn_mfma_f32_16x16x32_bf16(kf, qf[0][kk], st[0][n], 0, 0, 0);
                        st[1][n] = __builtin_amdgcn_mfma_f32_16x16x32_bf16(kf, qf[1][kk], st[1][n], 0, 0, 0);
                    }
                bf16x8 pb[2][2];
                {
                    const int s0 = kt * 64 + 16 * fq, tq0 = tpos0 + fr, tq1 = tpos0 + 16 + fr;
                    f32x2 run = (f32x2){0.f, 0.f};
#pragma unroll
                    for (int idx = 15; idx >= 0; --idx) {
                        const f32x2 xv = (f32x2){st[0][idx >> 2][idx & 3], st[1][idx >> 2][idx & 3]};
                        const f32x2 ax = __builtin_elementwise_abs(xv);
                        f32x2 e; e.x = __builtin_amdgcn_exp2f(-ax.x); e.y = __builtin_amdgcn_exp2f(-ax.y);
                        const f32x2 e1 = e + 1.0f;
                        f32x2 lg; lg.x = __builtin_amdgcn_logf(e1.x); lg.y = __builtin_amdgcn_logf(e1.y);
                        const f32x2 sp = __builtin_elementwise_max(xv, (f32x2){0.f, 0.f}) + lg;
                        const f32x2 lw = (xv - sp) + run;
                        st[0][idx >> 2][idx & 3] = lw.x; st[1][idx >> 2][idx & 3] = lw.y;
                        f32x2 dec; dec.x = (s0 + idx) < tq0 ? sp.x : 0.f; dec.y = (s0 + idx) < tq1 ? sp.y : 0.f;
                        run = run - dec;
                    }
                    f32x2 t16, t32, t48;
                    t16.x = __shfl(run.x, (lane + 16) & 63); t16.y = __shfl(run.y, (lane + 16) & 63);
                    t32.x = __shfl(run.x, (lane + 32) & 63); t32.y = __shfl(run.y, (lane + 32) & 63);
                    t48.x = __shfl(run.x, (lane + 48) & 63); t48.y = __shfl(run.y, (lane + 48) & 63);
                    const f32x2 z2 = (f32x2){0.f, 0.f};
                    const f32x2 higher = (fq < 3 ? t16 : z2) + (fq < 2 ? t32 : z2) + (fq < 1 ? t48 : z2);
                    const f32x2 base = (f32x2){C[0], C[1]} + higher;
                    const f32x2 tot = (run + t16) + (t32 + t48);
                    C[0] += tot.x; C[1] += tot.y;
                    float w0[16], w1[16];
#pragma unroll
                    for (int idx = 0; idx < 16; ++idx) {
                        const f32x2 a2 = (f32x2){st[0][idx >> 2][idx & 3], st[1][idx >> 2][idx & 3]} + base;
                        w0[idx] = (s0 + idx) < tq0 ? __builtin_amdgcn_exp2f(a2.x) : 0.f;
                        w1[idx] = (s0 + idx) < tq1 ? __builtin_amdgcn_exp2f(a2.y) : 0.f;
                    }
#pragma unroll
                    for (int k2 = 0; k2 < 2; ++k2) {
                        u32x4 pw; pw.x = cvt_pk_bf16(w0[8 * k2 + 0], w0[8 * k2 + 1]); pw.y = cvt_pk_bf16(w0[8 * k2 + 2], w0[8 * k2 + 3]); pw.z = cvt_pk_bf16(w0[8 * k2 + 4], w0[8 * k2 + 5]); pw.w = cvt_pk_bf16(w0[8 * k2 + 6], w0[8 * k2 + 7]);
                        pb[0][k2] = __builtin_bit_cast(bf16x8, pw);
                        u32x4 pv; pv.x = cvt_pk_bf16(w1[8 * k2 + 0], w1[8 * k2 + 1]); pv.y = cvt_pk_bf16(w1[8 * k2 + 2], w1[8 * k2 + 3]); pv.z = cvt_pk_bf16(w1[8 * k2 + 4], w1[8 * k2 + 5]); pv.w = cvt_pk_bf16(w1[8 * k2 + 6], w1[8 * k2 + 7]);
                        pb[1][k2] = __builtin_bit_cast(bf16x8, pv);
                    }
                }
#pragma unroll
                for (int k2 = 0; k2 < 2; ++k2)
#pragma unroll
                    for (int dt = 0; dt < 8; ++dt) {
                        const LAS bf16_t* a0 = Vl + (16 * fq + 8 * k2 + (fr >> 2)) * AT_P + 16 * dt + 4 * (fr & 3);
                        const s16x4 lo = __builtin_amdgcn_ds_read_tr16_b64_v4i16((LAS s16x4*)a0), hi = __builtin_amdgcn_ds_read_tr16_b64_v4i16((LAS s16x4*)(a0 + 4 * AT_P));
                        const bf16x8 vf = (bf16x8){lo[0], lo[1], lo[2], lo[3], hi[0], hi[1], hi[2], hi[3]};
                        o[0][dt] = __builtin_amdgcn_mfma_f32_16x16x32_bf16(vf, pb[0][k2], o[0][dt], 0, 0, 0);
                        o[1][dt] = __builtin_amdgcn_mfma_f32_16x16x32_bf16(vf, pb[1][k2], o[1][dt], 0, 0, 0);
                    }
                if (__builtin_amdgcn_ballot_w64(C[0] < -160.f && C[1] < -160.f) == ~0ull) { wdone = true;     if (lane == 0) misc[8 + wid] = 1; }
            }
        }
        asm volatile("s_waitcnt vmcnt(0)" ::: "memory");
        __syncthreads();
        if (tid == 0 && prev_pm >= 0) __hip_atomic_fetch_add(pcnt + 64 * prev_pm, 1u, __ATOMIC_RELAXED, __HIP_MEMORY_SCOPE_AGENT);
        if (active) {
#pragma unroll
            for (int mt = 0; mt < 2; ++mt)
#pragma unroll
                for (int dt = 0; dt < 8; ++dt) {
                    const size_t off = (size_t)(qrow0 + 16 * mt + fr) * DM + h * 128 + 16 * dt + 4 * fq;
                    const u32x2 zr = *(const u32x2*)(sz1 + off); const f32x4 a = o[mt][dt];
                    u32x2 w; w.x = cvt_pk_bf16(a[0] * bf_lo(zr.x), a[1] * bf_hi(zr.x)); w.y = cvt_pk_bf16(a[2] * bf_lo(zr.y), a[3] * bf_hi(zr.y));
                    st_wt8(y1 + off, w);
                }
        }
        if (smp) {
            asm volatile("s_waitcnt vmcnt(0)" ::: "memory");
            __syncthreads();
            if (tid == 0) __hip_atomic_fetch_add(pcnt + 64 * 32, 1u, __ATOMIC_RELAXED, __HIP_MEMORY_SCOPE_AGENT);
            cur_pm = -1;
        }
    }
    asm volatile("s_waitcnt vmcnt(0)" ::: "memory");
    __syncthreads();
    if (tid == 0 && cur_pm >= 0) __hip_atomic_fetch_add(pcnt + 64 * cur_pm, 1u, __ATOMIC_RELAXED, __HIP_MEMORY_SCOPE_AGENT);
}

__device__ __forceinline__ void final_phase(const Params& p, int G) {
    int tid_ = threadIdx.x; asm volatile("" : "+v"(tid_)); const int tid = tid_, lane = tid & 63, wave = tid >> 6;
    const float* ss2 = (const float*)(p.ws + WS_SS2);
    for (int m = blockIdx.x * 8 + wave; m < MT; m += G * 8) {
        const float s = wave_sum(lane < 32 ? ss2[(size_t)m * 32 + lane] : 0.f);
        const float rinv = __builtin_amdgcn_rsqf(s * (1.0f / DM) + 1e-6f);
        float* row = p.out + (size_t)m * DM;
#pragma unroll
        for (int j = 0; j < 8; ++j) { const f32x4 v = *(const f32x4*)(row + 4 * lane + 256 * j), gg = *(const f32x4*)(p.fng + 4 * lane + 256 * j); *(f32x4*)(row + 4 * lane + 256 * j) = v * rinv * gg; }
    }
}


#define XB_TMO      128
#define XB_XCNT(j)  (256  + 64 * (j))
#define XB_XSUB(j)  (1280 + 64 * (j))
#define XB_XGEN(j)  (2304 + 64 * (j))
#define XB_TOP      3328
#define XB_TOPGEN   3392
#define XCD_BAR_WORDS 3456
#define XB_SPIN_CAP (1u << 20)
__device__ __forceinline__ unsigned xb_ld(unsigned* p)              { return __hip_atomic_load(p, __ATOMIC_RELAXED, __HIP_MEMORY_SCOPE_AGENT); }
__device__ __forceinline__ unsigned xb_add(unsigned* p, unsigned v) { return __hip_atomic_fetch_add(p, v, __ATOMIC_RELAXED, __HIP_MEMORY_SCOPE_AGENT); }
__device__ __forceinline__ unsigned xb_xcc_id() { return (unsigned)__builtin_amdgcn_s_getreg((3 << 11) | 20) & 0xFu; }
#define XB_SPIN(cond, bar) do { unsigned _sp = 0; while (cond) { __builtin_amdgcn_s_sleep(1); \
    if ((++_sp & 255u) == 0u) { if (xb_ld(&(bar)[XB_TMO])) break; if (_sp > XB_SPIN_CAP) { atomicAdd(&(bar)[XB_TMO], 1u); break; } } } } while (0)
struct XcdBarrier { unsigned* bar; unsigned x; volatile LAS unsigned* st; };
__device__ __forceinline__ XcdBarrier xcd_barrier_post(unsigned* bar, volatile LAS unsigned* st) {
    XcdBarrier b; b.bar = bar; b.x = xb_xcc_id(); b.st = st;
    if (threadIdx.x == 0) (void)xb_add(&bar[XB_XCNT(b.x)], 1u);
    return b;
}
__device__ __forceinline__ void xcd_barrier_complete(unsigned* bar, unsigned x, unsigned& nloc, unsigned& nx) {
    const unsigned G = gridDim.x * gridDim.y * gridDim.z;
    unsigned sum, cnt, mine, sp = 0u;
    for (;;) {
        sum = 0u; cnt = 0u; mine = 0u;
#pragma unroll
        for (unsigned j = 0; j < 16; ++j) { const unsigned c = xb_ld(&bar[XB_XCNT(j)]); sum += c; cnt += (c > 0u) ? 1u : 0u; mine = (j == x) ? c : mine; }
        if (sum == G) break;
        __builtin_amdgcn_s_sleep(1);
        if ((++sp & 255u) == 0u) { if (xb_ld(&bar[XB_TMO])) break; if (sp > XB_SPIN_CAP) { atomicAdd(&bar[XB_TMO], 1u); break; } }
    }
    nloc = mine > 0u ? mine : 1u; nx = cnt > 0u ? cnt : 1u;
}
__device__ __forceinline__ void xcd_barrier(const XcdBarrier& b) {
    asm volatile("s_waitcnt vmcnt(0)" ::: "memory");
    __syncthreads();
    if (threadIdx.x == 0) {
        unsigned* bar = b.bar;
        __builtin_amdgcn_s_waitcnt(0);
        unsigned nloc = b.st[0], nx = b.st[1];
        if (nloc == 0u) { xcd_barrier_complete(bar, b.x, nloc, nx); b.st[0] = nloc; b.st[1] = nx; }
        const unsigned old = xb_add(&bar[XB_XSUB(b.x)], 1u);
        const unsigned gen = old / nloc;
        if (old + 1u == (gen + 1u) * nloc) {
            __builtin_amdgcn_fence(__ATOMIC_RELEASE, "agent");
            asm volatile("s_waitcnt vmcnt(0)" ::: "memory");
            const unsigned og = xb_add(&bar[XB_TOP], 1u);
            const unsigned tg = og / nx;
            if (og + 1u == (tg + 1u) * nx) xb_add(&bar[XB_TOPGEN], 1u);
            else XB_SPIN(xb_ld(&bar[XB_TOPGEN]) == tg, bar);
            __builtin_amdgcn_fence(__ATOMIC_ACQUIRE, "agent");
            xb_add(&bar[XB_XGEN(b.x)], 1u);
            asm volatile("s_waitcnt vmcnt(0)" ::: "memory");
        } else {
            XB_SPIN(xb_ld(&bar[XB_XGEN(b.x)]) == gen, bar);
            __builtin_amdgcn_fence(__ATOMIC_ACQUIRE, "agent");
            asm volatile("s_waitcnt vmcnt(0)" ::: "memory");
        }
    }
    __syncthreads();
}

#ifndef DUP
#define DUP 0
#endif
constexpr int LDS_BYTES = 131072 + 4096 + 8192;
__global__ void __launch_bounds__(512, 2) fwd_megakernel(Params p) {
    extern __shared__ __attribute__((aligned(16))) unsigned char lds_raw[];
    LAS unsigned char* lds = (LAS unsigned char*)lds_raw;
    cg::grid_group grid = cg::this_grid();
    const int G = gridDim.x;
    bf16_t* RA = (bf16_t*)(p.ws + WS_RA); bf16_t* RB = (bf16_t*)(p.ws + WS_RB);
    volatile LAS unsigned* xst = (volatile LAS unsigned*)(lds + 131072 + 2048);
    if (threadIdx.x < 4) xst[threadIdx.x] = 0u;
    __syncthreads();
    const XcdBarrier xbar = xcd_barrier_post((unsigned*)(p.ws + WS_CTL) + 1024, xst);
    p0_prologue(p, lds, G);
    if (DUP == 1) { __syncthreads(); p0_prologue(p, lds, G); }
    if (p.ws == nullptr) grid.sync();
    xcd_barrier(xbar);
    {
        pg8::Gemm g{RA, (const bf16_t*)(p.ws + WS_W1T), MT, N1, DM}; pg8::OrderG1 S; S.init(G, (int)blockIdx.x, (unsigned*)(p.ws + WS_CTL) + 11264);
        EpiG1 E{RB, (f32x2*)(p.ws + WS_LNP), (LAS f32x2*)(lds + 131072 + 4096)};
        pg8::gemm_phase<EpiG1, pg8::OrderG1>(lds, g, S, E);
    }
    mix_phase(p, lds, G, false);
    xcd_barrier(xbar);
    {
        unsigned* cnt = (unsigned*)(p.ws + WS_CTL) + 5120;
        {
            pg8::Gemm g{RB, (const bf16_t*)(p.ws + WS_W2T), MT, DM, GW}; pg8::OrderG2 S; S.init(G, (int)blockIdx.x, cnt);
            EpiRes<true> E{p.xp, p.xs, p.out, RA, (float*)(p.ws + WS_SS1)};
            pg8::gemm_phase<EpiRes<true>, pg8::OrderG2>(lds, g, S, E);
        }
        {
            pg8::Gemm g{RA, (const bf16_t*)(p.ws + WS_W3T), MT, N3, DM}; pg8::OrderG3 S; S.init(G, (int)blockIdx.x, cnt);
            EpiG3 E{RB + 2 * SZ_D, (const float*)(p.ws + WS_SS1), p.out};
            pg8::gemm_phase<EpiG3, pg8::OrderG3>(lds, g, S, E);
        }
    }
    xcd_barrier(xbar);
    if (!(G == 256 && blockIdx.x < 8)) attn_phase(p, lds, 0);
    if (G == 256) {
        pg8::Gemm g{RB, (const bf16_t*)(p.ws + WS_W4T), MT, DM, DM}; pg8::OrderG4 S; S.init(G, (int)blockIdx.x, (unsigned*)(p.ws + WS_CTL) + 8192);
        EpiFinal E{p.out, (float*)(p.ws + WS_SS2), p.fng, (unsigned*)(p.ws + WS_CTL) + 14336};
        pg8::gemm_phase<EpiFinal, pg8::OrderG4>(lds, g, S, E);
        return;
    }
    {
        pg8::Gemm g{RB, (const bf16_t*)(p.ws + WS_W4T), MT, DM, DM}; pg8::OrderG4 S; S.init(G, (int)blockIdx.x, (unsigned*)(p.ws + WS_CTL) + 8192);
        EpiRes<false> E{nullptr, nullptr, p.out, nullptr, (float*)(p.ws + WS_SS2)};
        pg8::gemm_phase<EpiRes<false>, pg8::OrderG4>(lds, g, S, E);
    }
    xcd_barrier(xbar);
    final_phase(p, G);
}

extern "C" void kernel_launch(void* const* d_in, const int* in_sizes, int n_in, void* d_out, int out_size, void* d_ws, size_t ws_size, hipStream_t stream) {
    static int grid_blocks = 0;
    if (!grid_blocks) {
        int dev = 0, cus = 0, per_cu = 0;
        (void)hipGetDevice(&dev);
        (void)hipDeviceGetAttribute(&cus, hipDeviceAttributeMultiprocessorCount, dev);
        (void)hipFuncSetAttribute((const void*)fwd_megakernel, hipFuncAttributeMaxDynamicSharedMemorySize, LDS_BYTES);
        (void)hipOccupancyMaxActiveBlocksPerMultiprocessor(&per_cu, (const void*)fwd_megakernel, 512, LDS_BYTES);
        if (per_cu < 1) per_cu = 1;
        grid_blocks = cus * per_cu;
        if (ws_size < 348 * MiB) fprintf(stderr, "kernel_launch: workspace too small: %zu\n", ws_size);
    }
    (void)hipMemsetAsync((char*)d_ws + WS_CTL, 0, 131072, stream);
    Params p{};
    p.xp = (const float*)d_in[0]; p.xs = (const float*)d_in[1]; p.ck = (const float*)d_in[2]; p.cv = (const float*)d_in[3]; p.norm_g = (const float*)d_in[4]; p.fng = (const float*)d_in[5];
    p.w1 = (const float*)d_in[6]; p.lng = (const float*)d_in[7]; p.lnb = (const float*)d_in[8]; p.wsp = (const float*)d_in[9]; p.bsp = (const float*)d_in[10]; p.w2 = (const float*)d_in[11];
    p.w3 = (const float*)d_in[12]; p.w4 = (const float*)d_in[13]; p.out = (float*)d_out; p.ws = (unsigned char*)d_ws;
    void* args[] = {&p};
    hipError_t e = hipLaunchCooperativeKernel((void*)fwd_megakernel, dim3(grid_blocks), dim3(512), args, LDS_BYTES, stream);
    if (e != hipSuccess) fprintf(stderr, "cooperative launch failed: %s (grid %d)\n", hipGetErrorString(e), grid_blocks);
}
```

```cpp
#include <hip/hip_runtime.h>
#include <hip/hip_cooperative_groups.h>
#include <cstdio>
#include <cstdint>
namespace cg = cooperative_groups;

#define LAS __attribute__((address_space(3)))
typedef unsigned short bf16_t;
typedef short bf16x8 __attribute__((ext_vector_type(8)));
typedef short s16x4 __attribute__((ext_vector_type(4)));
typedef float f32x4 __attribute__((ext_vector_type(4)));
typedef float f32x2 __attribute__((ext_vector_type(2)));
typedef unsigned u32x4 __attribute__((ext_vector_type(4)));
typedef unsigned u32x2 __attribute__((ext_vector_type(2)));

constexpr int DM = 2048, MP = 8192, MS = 256, MT = MP + MS;
constexpr int GW = 4096, N1 = 3 * GW, N3 = 4 * DM;
constexpr size_t MiB = 1u << 20;
constexpr size_t WS_CTL = 0;
constexpr size_t WS_W1T = 4 * MiB, WS_W2T = 52 * MiB, WS_W3T = 68 * MiB, WS_W4T = 100 * MiB;
constexpr size_t WS_RA = 108 * MiB;
constexpr size_t WS_RB = 141 * MiB;
constexpr size_t WS_LNP = 339 * MiB;
constexpr size_t WS_SS1 = 344 * MiB;
constexpr size_t WS_SS2 = 346 * MiB;
constexpr size_t SZ_G = (size_t)MT * GW;
constexpr size_t SZ_D = (size_t)MT * DM;
constexpr size_t O_YP = 0, O_YS = (size_t)MP * DM, O_KP = O_YS + (size_t)MS * DM, O_VP = O_KP + (size_t)MP * DM, O_KS = O_VP + (size_t)MP * DM, O_VS = O_KS + (size_t)MS * DM, O_GMV = O_VS + (size_t)MS * DM;

struct Params {
    const float* xp; const float* xs; const float* ck; const float* cv; const float* norm_g; const float* fng;
    const float* w1; const float* lng; const float* lnb; const float* wsp; const float* bsp; const float* w2; const float* w3; const float* w4;
    float* out; unsigned char* ws;
};

__device__ __forceinline__ unsigned cvt_pk_bf16(float lo, float hi) { unsigned r; asm volatile("v_cvt_pk_bf16_f32 %0, %1, %2" : "=v"(r) : "v"(lo), "v"(hi)); return r; }
__device__ __forceinline__ void st_wt16(void* ptr, u32x4 v) { asm volatile("global_store_dwordx4 %0, %1, off sc1\n\ts_nop 1" :: "v"(ptr), "v"(v) : "memory"); }
__device__ __forceinline__ void st_wt8(void* ptr, u32x2 v) { asm volatile("global_store_dwordx2 %0, %1, off sc1" :: "v"(ptr), "v"(v) : "memory"); }
__device__ __forceinline__ void st_wt4(void* ptr, unsigned v) { asm volatile("global_store_dword %0, %1, off sc1" :: "v"(ptr), "v"(v) : "memory"); }
__device__ __forceinline__ float bf_lo(unsigned w) { return __uint_as_float(w << 16); }
__device__ __forceinline__ float bf_hi(unsigned w) { return __uint_as_float(w & 0xffff0000u); }
__device__ __forceinline__ float fast_sigmoid_mul(float x, float arg) { return x * __builtin_amdgcn_rcpf(1.0f + __builtin_amdgcn_exp2f(-1.4426950408889634f * arg)); }
__device__ __forceinline__ float gelu_tanh(float x) { return fast_sigmoid_mul(x, x * (1.5957691216057308f + 0.07135481627260025f * x * x)); }
__device__ __forceinline__ float silu(float x) { return fast_sigmoid_mul(x, x); }
__device__ __forceinline__ f32x2 exp2_2(f32x2 a) { f32x2 r; r.x = __builtin_amdgcn_exp2f(a.x); r.y = __builtin_amdgcn_exp2f(a.y); return r; }
__device__ __forceinline__ f32x2 rcp_2(f32x2 a) { f32x2 r; r.x = __builtin_amdgcn_rcpf(a.x); r.y = __builtin_amdgcn_rcpf(a.y); return r; }
__device__ __forceinline__ f32x2 gelu_den2(f32x2 x) { return exp2_2(x * ((x * x) * (-0.10294324f) + (-2.3022082f))) + 1.0f; }
__device__ __forceinline__ f32x2 silu_den2(f32x2 x) { return exp2_2(x * (-1.4426950408889634f)) + 1.0f; }
__device__ __forceinline__ f32x2 gelu2(f32x2 x) { return x * rcp_2(gelu_den2(x)); }
__device__ __forceinline__ f32x2 silu2(f32x2 x) { return x * rcp_2(silu_den2(x)); }
__device__ __forceinline__ f32x2 guz2(f32x2 u, f32x2 z) { return (u * z) * rcp_2(gelu_den2(u) * silu_den2(z)); }
__device__ __forceinline__ float wave_sum(float v) {
#pragma unroll
    for (int o = 1; o < 64; o <<= 1) v += __shfl_xor(v, o);
    return v;
}

namespace pg8 {
constexpr int BM = 256, BK = 64, HALF = 128, HTB = HALF * BK * 2, STAGE_BYTES = 8 * HTB, NXCD = 8, WGM = 8;
__host__ __device__ __forceinline__ int lds_byte(int r, int c) { const int st = (r >> 4) * 2 + (c >> 5), rr = r & 15, cc = c & 31, ob = rr * 64 + cc * 2; return st * 1024 + (ob ^ (((ob >> 9) & 1) << 5)); }
__host__ __device__ __forceinline__ void stage_rc(int b, int& R, int& C) { const int st = b / 1024, sb = b % 1024, swz = sb ^ (((sb >> 9) & 1) << 5); R = (st >> 1) * 16 + swz / 64; C = (st & 1) * 32 + (swz % 64) / 2; }
__host__ __device__ __forceinline__ int perm32(int rho) { const int n = rho >> 4, i = rho & 15; return 8 * (i >> 2) + 4 * n + (i & 3); }
struct Unit { int pm, pn; };
struct Gemm { const bf16_t* A; const bf16_t* Bt; int M, N, K; };
struct StaticOrder {
    static constexpr bool PUBLISH = false; unsigned* cnt = nullptr; unsigned* pub = nullptr;
    int nM, nN, nwg, G, c;
    __host__ __device__ void init(int M, int N, int G_, int c_) { nM = M / BM; nN = N / BM; nwg = nM * nN; G = G_; c = c_; }
    __host__ __device__ bool next(int i, Unit& u) const {
        const long L = (long)i * G + c; if (L >= nwg) return false;
        int wgid = (int)L; { const int q = nwg / NXCD, r = nwg % NXCD, xcd = wgid % NXCD, off = wgid / NXCD; wgid = (xcd < r ? xcd * (q + 1) : r * (q + 1) + (xcd - r) * q) + off; }
        const int nig = WGM * nN, gid = wgid / nig, fm = gid * WGM, gsz = (nM - fm) < WGM ? (nM - fm) : WGM;
        u.pm = fm + ((wgid % nig) % gsz); u.pn = (wgid % nig) / gsz; return true;
    }
    __device__ __forceinline__ void a_ready(const Unit&) const {}
    __device__ __forceinline__ void done(const Unit&) const {}
};
__device__ __forceinline__ void panel_publish(unsigned* cnt, int pm) {
    asm volatile("s_waitcnt vmcnt(0)" ::: "memory");
    __builtin_amdgcn_s_barrier();
    if (threadIdx.x < 64) {
        __builtin_amdgcn_fence(__ATOMIC_RELEASE, "agent");
        asm volatile("s_waitcnt vmcnt(0)" ::: "memory");
        if (threadIdx.x == 0) __hip_atomic_fetch_add(cnt + 64 * pm, 1u, __ATOMIC_RELAXED, __HIP_MEMORY_SCOPE_AGENT);
    }
}
__device__ __forceinline__ void panel_publish_wt(unsigned* cnt, int pm) {
    asm volatile("s_waitcnt vmcnt(0)" ::: "memory");
    __builtin_amdgcn_s_barrier();
    if (threadIdx.x == 0) __hip_atomic_fetch_add(cnt + 64 * pm, 1u, __ATOMIC_RELAXED, __HIP_MEMORY_SCOPE_AGENT);
}
__device__ __forceinline__ void panel_wait_wave0(unsigned* cnt, int pm, unsigned need) {
    unsigned polls = 0;
    while ((unsigned)__builtin_amdgcn_readfirstlane(__hip_atomic_load(cnt + 64 * pm, __ATOMIC_RELAXED, __HIP_MEMORY_SCOPE_AGENT)) < need) {
        __builtin_amdgcn_s_sleep(2);
        if (++polls > (1u << 22)) break;
    }
    __builtin_amdgcn_fence(__ATOMIC_ACQUIRE, "agent");
    asm volatile("s_waitcnt vmcnt(0)" ::: "memory");
}
struct OrderG1 {
    static constexpr bool PUBLISH = true;
    StaticOrder P; unsigned* cnt; unsigned* pub; int G, c;
    __device__ void init(int G_, int c_, unsigned* cnt_) { P.init(8192, 12288, G_, c_); G = G_; c = c_; cnt = cnt_; pub = cnt_; }
    __device__ bool next(int i, Unit& u) const { const int L = i * G + c; if (L < 1536) return P.next(i, u); if (L < 1584) { u.pm = 32; u.pn = L - 1536; return true; } return false; }
    __device__ __forceinline__ void a_ready(const Unit&) const {}
    __device__ __forceinline__ void done(const Unit& u) const { panel_publish_wt(cnt, u.pm); }
};
struct OrderG2 {
    static constexpr bool PUBLISH = true;
    StaticOrder P; unsigned* cnt; unsigned* pub; int G, c;
    __device__ void init(int G_, int c_, unsigned* cnt_) { P.init(8192, 2048, G_, c_); G = G_; c = c_; cnt = cnt_; pub = cnt_; }
    __device__ bool next(int i, Unit& u) const { const int L = i * G + c; if (L < 256) return P.next(i, u); if (L < 264) { u.pm = 32; u.pn = L - 256; return true; } return false; }
    __device__ __forceinline__ void a_ready(const Unit&) const {}
    __device__ __forceinline__ void done(const Unit& u) const { panel_publish_wt(cnt, u.pm); }
};
struct OrderG3 {
    static constexpr bool PUBLISH = true;
    StaticOrder P; unsigned* cnt; unsigned* pub; int G, c;
    __device__ void init(int G_, int c_, unsigned* cnt_, unsigned* pub_) { P.init(8192, 8192, G_, c_); G = G_; c = c_; cnt = cnt_; pub = pub_; }
    __device__ bool next(int i, Unit& u) const {
        if (G == 256) {
            if (i < 4) {
                if (c < 8 && i >= 2) return false;
                P.next(i, u);
                if ((u.pm & 7) == 7 && (u.pn < 4 || (u.pn >= 8 && u.pn < 16))) {
                    if (u.pn >= 8) { const int r = (u.pm >> 3) * 8 + (u.pn - 8); u.pm = 32; u.pn = r; }
                    else { const int j = (u.pm >> 3) * 4 + u.pn; StaticOrder Q = P; Q.c = j & 7; Q.next(2 + (j >> 3), u); }
                }
                return true;
            }
            if (i == 4 && c >= 8 && c < 56) { const int r = c - 8; if (r < 32) { u.pm = 8 * (r >> 3) + 7; u.pn = 8 + (r & 7); } else { const int j = r - 32; u.pm = 8 * (j >> 2) + 7; u.pn = j & 3; } return true; }
            return false;
        }
        const int L = i * G + c; if (L < 1024) return P.next(i, u); if (L < 1056) { u.pm = 32; u.pn = L - 1024; return true; } return false;
    }
    __device__ __forceinline__ void a_ready(const Unit& u) const {
        if (threadIdx.x < 64) panel_wait_wave0(cnt, u.pm, 8u);
        asm volatile("" ::: "memory"); __builtin_amdgcn_s_barrier(); asm volatile("" ::: "memory");
    }
    __device__ __forceinline__ void done(const Unit&) const {}
};
struct OrderG4 {
    static constexpr bool PUBLISH = false;
    StaticOrder P; unsigned* cnt; unsigned* pub = nullptr; int G, c;
    __device__ void init(int G_, int c_, unsigned* cnt_) { P.init(8192, 2048, G_, c_); G = G_; c = c_; cnt = cnt_; }
    __device__ bool next(int i, Unit& u) const {
        if (G == 256) { if (c < 8) { if (i == 0) { u.pm = 32; u.pn = c; return true; } return i == 1 ? P.next(0, u) : false; } return i == 0 ? P.next(0, u) : false; }
        const int L = i * G + c; if (L < 256) return P.next(i, u); if (L < 264) { u.pm = 32; u.pn = L - 256; return true; } return false;
    }
    __device__ __forceinline__ void a_ready(const Unit& u) const {
        if (threadIdx.x < 64) panel_wait_wave0(cnt, u.pm, u.pm == 32 ? 128u : 16u);
        asm volatile("" ::: "memory"); __builtin_amdgcn_s_barrier(); asm volatile("" ::: "memory");
    }
    __device__ __forceinline__ void done(const Unit&) const {}
};

template <class Epi, class Sched, bool ALIGN_EPI = true>
__device__ __forceinline__ void gemm_phase(LAS unsigned char* lds, const Gemm g, const Sched& S, const Epi& E) {
    int tid_ = threadIdx.x; asm volatile("" : "+v"(tid_)); const int tid = tid_, wid = __builtin_amdgcn_readfirstlane(tid >> 6), lane = tid & 63, wr = wid >> 2, wc = wid & 3, fr = lane & 15, fq = lane >> 4;
    const int K = g.K, nt = K / BK;
    unsigned voffA[2], voffB[2];
#pragma unroll
    for (int i = 0; i < 2; ++i) { int R, C; stage_rc(tid * 16 + i * 8192, R, C); const int Rb = Epi::PERM ? ((R & ~31) + perm32(R & 31)) : R;
        voffA[i] = (unsigned)(R * K + C) * 2u; voffB[i] = (unsigned)(Rb * K + C) * 2u; }
    const size_t kstep = (size_t)(BK * 2);
    const size_t hstep = (size_t)HALF * K * 2;
    const size_t tstep = 2 * hstep;
    const unsigned ldsw = (unsigned)wid * 1024u;
    const int aoff = lds_byte(wr * 64 + fr, fq * 8), boff = lds_byte(wc * 32 + fr, fq * 8);
#define PG8_SA(b, h) (((b) * 2 + (h)) * HTB)
#define PG8_SB(b, h) ((4 + (b) * 2 + (h)) * HTB)
#define PG8_STAGE(bufoff, gbase, voff) do { _Pragma("unroll") for (int _i = 0; _i < 2; ++_i) \
        __builtin_amdgcn_global_load_lds((const unsigned*)((const char*)(gbase) + (voff)[_i]), (LAS unsigned*)(lds + (bufoff) + ldsw + _i * 8192), 16, 0, 0); } while (0)
#define PG8_LDA(dst, b, h) do { _Pragma("unroll") for (int m = 0; m < 4; ++m) _Pragma("unroll") for (int k = 0; k < 2; ++k) dst[m][k] = *(const LAS bf16x8*)(lds + PG8_SA(b, h) + aoff + m * 2048 + k * 1024); } while (0)
#define PG8_LDB(dst, b, h) do { _Pragma("unroll") for (int n = 0; n < 2; ++n) _Pragma("unroll") for (int k = 0; k < 2; ++k) dst[n][k] = *(const LAS bf16x8*)(lds + PG8_SB(b, h) + boff + n * 2048 + k * 1024); } while (0)
#define PG8_MMA(ai, bj, At, Bt) do { __builtin_amdgcn_s_setprio(1); _Pragma("unroll") for (int m = 0; m < 4; ++m) _Pragma("unroll") for (int n = 0; n < 2; ++n) _Pragma("unroll") for (int k = 0; k < 2; ++k) \
        acc[ai][bj][m][n] = __builtin_amdgcn_mfma_f32_16x16x32_bf16(Bt[n][k], At[m][k], acc[ai][bj][m][n], 0, 0, 0); __builtin_amdgcn_s_setprio(0); } while (0)
#define PG8_WAIT_V(n) asm volatile("s_waitcnt vmcnt(" #n ")" ::: "memory")
#define PG8_WAIT_L(n) asm volatile("s_waitcnt lgkmcnt(" #n ")" ::: "memory")
#define PG8_BAR __builtin_amdgcn_s_barrier()
#define PG8_SCHED __builtin_amdgcn_sched_barrier(0)
    Unit cur, nxt; int ui = 0; int pend = -1;
    if (!S.next(0, cur)) return;
    f32x4 acc[2][2][4][2];
#pragma unroll
    for (int a = 0; a < 2; ++a)
#pragma unroll
        for (int b = 0; b < 2; ++b)
#pragma unroll
            for (int m = 0; m < 4; ++m)
#pragma unroll
                for (int n = 0; n < 2; ++n) acc[a][b][m][n] = (f32x4){0.f, 0.f, 0.f, 0.f};
    bf16x8 At[4][2], B0[2][2], B1[2][2];
    const char* cA = (const char*)g.A + (size_t)cur.pm * tstep; const char* cB = (const char*)g.Bt + (size_t)cur.pn * tstep;
    S.a_ready(cur);
    PG8_STAGE(PG8_SB(0, 0), cB, voffB); PG8_STAGE(PG8_SB(0, 1), cB + hstep, voffB); PG8_STAGE(PG8_SA(0, 0), cA, voffA); PG8_STAGE(PG8_SA(0, 1), cA + hstep, voffA);
    if (wr == 1) PG8_BAR;
    PG8_WAIT_V(2); PG8_BAR;
    PG8_STAGE(PG8_SB(1, 0), cB + kstep, voffB); PG8_STAGE(PG8_SA(1, 0), cA + kstep, voffA); PG8_STAGE(PG8_SB(1, 1), cB + hstep + kstep, voffB);
    PG8_WAIT_V(6); PG8_BAR;
    for (;;) {
        const bool has_next = S.next(ui + 1, nxt);
        const char* nA = has_next ? (const char*)g.A + (size_t)nxt.pm * tstep : cA; const char* nB = has_next ? (const char*)g.Bt + (size_t)nxt.pn * tstep : cB;
        for (int t = 0; t < nt; t += 2) {
            const bool last = (t == nt - 2);
            const char* a1 = cA + (size_t)(t + 1) * kstep;
            const char* a2 = last ? nA : cA + (size_t)(t + 2) * kstep; const char* b2 = last ? nB : cB + (size_t)(t + 2) * kstep;
            const char* a3 = a2 + kstep; const char* b3 = b2 + kstep;
            if (last && has_next) S.a_ready(nxt);
            if (Sched::PUBLISH && t == 4 && pend >= 0) {
                if (tid == 0) __hip_atomic_fetch_add(S.pub + 64 * pend, 1u, __ATOMIC_RELAXED, __HIP_MEMORY_SCOPE_AGENT);
                pend = -1;
            }
            PG8_LDB(B0, 0, 0); PG8_LDB(B1, 0, 1); PG8_SCHED; PG8_LDA(At, 0, 0); PG8_STAGE(PG8_SA(1, 1), a1 + hstep, voffA);
            PG8_WAIT_V(8); PG8_WAIT_L(0); PG8_BAR; PG8_MMA(0, 0, At, B0); PG8_MMA(0, 1, At, B1); PG8_BAR; PG8_SCHED;
            PG8_LDA(At, 0, 1); PG8_STAGE(PG8_SB(0, 0), b2, voffB); PG8_STAGE(PG8_SB(0, 1), b2 + hstep, voffB); PG8_STAGE(PG8_SA(0, 0), a2, voffA);
            PG8_WAIT_V(8); PG8_WAIT_L(0); PG8_BAR; PG8_MMA(1, 0, At, B0); PG8_MMA(1, 1, At, B1); PG8_BAR; PG8_SCHED;
            PG8_LDB(B0, 1, 0); PG8_LDB(B1, 1, 1); PG8_SCHED; PG8_LDA(At, 1, 0); PG8_STAGE(PG8_SA(0, 1), a2 + hstep, voffA);
            PG8_WAIT_V(8); PG8_WAIT_L(0); PG8_BAR; PG8_MMA(0, 0, At, B0); PG8_MMA(0, 1, At, B1); PG8_BAR; PG8_SCHED;
            PG8_LDA(At, 1, 1); PG8_STAGE(PG8_SB(1, 0), b3, voffB); PG8_STAGE(PG8_SB(1, 1), b3 + hstep, voffB); PG8_STAGE(PG8_SA(1, 0), a3, voffA);
            PG8_WAIT_V(8); PG8_WAIT_L(0); PG8_BAR; PG8_MMA(1, 0, At, B0); PG8_MMA(1, 1, At, B1); PG8_BAR; PG8_SCHED;
        }
        if constexpr (ALIGN_EPI) { if (wr == 0) PG8_BAR; }
        E(acc, cur, wr, wc, fr, fq); if (Sched::PUBLISH) pend = cur.pm;
        if (!has_next) break;
#pragma unroll
        for (int a = 0; a < 2; ++a)
#pragma unroll
            for (int b = 0; b < 2; ++b)
#pragma unroll
                for (int m = 0; m < 4; ++m)
#pragma unroll
                    for (int n = 0; n < 2; ++n) acc[a][b][m][n] = (f32x4){0.f, 0.f, 0.f, 0.f};
        cur = nxt; cA = nA; cB = nB; ++ui;
        if constexpr (ALIGN_EPI) { if (wr == 1) PG8_BAR; }
    }
    PG8_WAIT_V(0);
    if constexpr (!ALIGN_EPI) { if (wr == 0) PG8_BAR; }
    PG8_BAR;
    if (Sched::PUBLISH && pend >= 0 && tid == 0) __hip_atomic_fetch_add(S.pub + 64 * pend, 1u, __ATOMIC_RELAXED, __HIP_MEMORY_SCOPE_AGENT);
#undef PG8_SA
#undef PG8_SB
#undef PG8_STAGE
#undef PG8_LDA
#undef PG8_LDB
#undef PG8_MMA
#undef PG8_WAIT_V
#undef PG8_WAIT_L
#undef PG8_BAR
#undef PG8_SCHED
}
}

struct EpiG1 {
    static constexpr bool PERM = true;
    bf16_t* rb; f32x2* lnp; LAS f32x2* red;
    __device__ __forceinline__ void operator()(const f32x4 (&acc)[2][2][4][2], const pg8::Unit& u, int wr, int wc, int fr, int fq) const {
        const int row0 = u.pm * 256 + wr * 64 + fr;
        if (u.pn < 32) {
            const int col0 = u.pn * 128 + wc * 32 + 8 * fq;
#pragma unroll
            for (int ai = 0; ai < 2; ++ai)
#pragma unroll
                for (int m = 0; m < 4; ++m) {
                    const int row = row0 + ai * 128 + m * 16;
                    const f32x4 u0 = acc[ai][0][m][0], u1 = acc[ai][0][m][1], z0 = acc[ai][1][m][0], z1 = acc[ai][1][m][1];
                    const f32x2 a = guz2((f32x2){u0[0], u0[1]}, (f32x2){z0[0], z0[1]}), b = guz2((f32x2){u0[2], u0[3]}, (f32x2){z0[2], z0[3]});
                    const f32x2 c = guz2((f32x2){u1[0], u1[1]}, (f32x2){z1[0], z1[1]}), d = guz2((f32x2){u1[2], u1[3]}, (f32x2){z1[2], z1[3]});
                    u32x4 w; w.x = cvt_pk_bf16(a.x, a.y); w.y = cvt_pk_bf16(b.x, b.y); w.z = cvt_pk_bf16(c.x, c.y); w.w = cvt_pk_bf16(d.x, d.y);
                    st_wt16(rb + (size_t)row * GW + col0, w);
                }
        } else {
            const int pv = u.pn - 32;
            bf16_t* base = rb + SZ_G;
            const int col0 = pv * 256 + wc * 32 + 8 * fq;
#pragma unroll
            for (int ai = 0; ai < 2; ++ai)
#pragma unroll
                for (int m = 0; m < 4; ++m) {
                    const int row = row0 + ai * 128 + m * 16;
                    bf16_t* rowp = base + (size_t)row * GW + col0;
                    f32x2 s2 = (f32x2){0.f, 0.f}, q2 = s2;
#pragma unroll
                    for (int bj = 0; bj < 2; ++bj) {
                        const f32x4 x0 = acc[ai][bj][m][0], x1 = acc[ai][bj][m][1];
                        const f32x2 a = gelu2((f32x2){x0[0], x0[1]}), b = gelu2((f32x2){x0[2], x0[3]}), c = gelu2((f32x2){x1[0], x1[1]}), d = gelu2((f32x2){x1[2], x1[3]});
                        s2 += (a + b) + (c + d); q2 += (a * a + b * b) + (c * c + d * d);
                        u32x4 w; w.x = cvt_pk_bf16(a.x, a.y); w.y = cvt_pk_bf16(b.x, b.y); w.z = cvt_pk_bf16(c.x, c.y); w.w = cvt_pk_bf16(d.x, d.y);
                        st_wt16(rowp + bj * 128, w);
                    }
                    float s = s2.x + s2.y, q = q2.x + q2.y;
                    s += __shfl_xor(s, 16); s += __shfl_xor(s, 32); q += __shfl_xor(q, 16); q += __shfl_xor(q, 32);
                    if (fq == 0) red[(ai * 128 + wr * 64 + m * 16 + fr) * 4 + wc] = (f32x2){s, q};
                }
            asm volatile("s_waitcnt lgkmcnt(0)" ::: "memory"); __builtin_amdgcn_s_barrier(); asm volatile("" ::: "memory");
            if (threadIdx.x < 256) {
                const int r = threadIdx.x; const f32x2 a = red[r * 4 + 0], b = red[r * 4 + 1], c = red[r * 4 + 2], d = red[r * 4 + 3];
                st_wt8(lnp + (size_t)(u.pm * 256 + r) * 16 + pv, (u32x2){__float_as_uint((a[0] + b[0]) + (c[0] + d[0])), __float_as_uint((a[1] + b[1]) + (c[1] + d[1]))});
            }
        }
    }
};
template <bool FIRST> struct EpiRes {
    static constexpr bool PERM = false;
    const float* xp; const float* xs; float* oy; bf16_t* xb; float* ss;
    __device__ __forceinline__ void operator()(const f32x4 (&acc)[2][2][4][2], const pg8::Unit& u, int wr, int wc, int fr, int fq) const {
        const int row0 = u.pm * 256 + wr * 64 + fr, col0 = u.pn * 256 + wc * 32 + 4 * fq;
#pragma unroll
        for (int ai = 0; ai < 2; ++ai)
#pragma unroll
            for (int m = 0; m < 4; ++m) {
                const int row = row0 + ai * 128 + m * 16;
                float* orow = oy + (size_t)row * DM + col0;
                const float* xr = FIRST ? ((row < MP ? xp + (size_t)row * DM : xs + (size_t)(row - MP) * DM) + col0) : orow;
                float q = 0.f;
#pragma unroll
                for (int bj = 0; bj < 2; ++bj)
#pragma unroll
                    for (int n = 0; n < 2; ++n) {
                        const f32x4 xv = *(const f32x4*)(xr + bj * 128 + n * 16);
                        const f32x4 o = xv + acc[ai][bj][m][n];
                        *(f32x4*)(orow + bj * 128 + n * 16) = o;
                        q += (o[0] * o[0] + o[1] * o[1]) + (o[2] * o[2] + o[3] * o[3]);
                        if (FIRST) { u32x2 w; w.x = cvt_pk_bf16(o[0], o[1]); w.y = cvt_pk_bf16(o[2], o[3]); st_wt8(xb + (size_t)row * DM + col0 + bj * 128 + n * 16, w); }
                    }
                q += __shfl_xor(q, 16); q += __shfl_xor(q, 32);
                if (fq == 0) { if (FIRST) st_wt4(ss + (size_t)row * 32 + u.pn * 4 + wc, __float_as_uint(q)); else ss[(size_t)row * 32 + u.pn * 4 + wc] = q; }
            }
    }
};
struct EpiFinal {
    static constexpr bool PERM = false;
    float* oy; float* ss; const float* fng; unsigned* cnt;
    __device__ __forceinline__ void operator()(f32x4 (&acc)[2][2][4][2], const pg8::Unit& u, int wr, int wc, int fr, int fq) const {
        const int row0 = u.pm * 256 + wr * 64 + fr, col0 = u.pn * 256 + wc * 32 + 4 * fq;
#pragma unroll
        for (int ai = 0; ai < 2; ++ai)
#pragma unroll
            for (int m = 0; m < 4; ++m) {
                const int row = row0 + ai * 128 + m * 16;
                const float* xr = oy + (size_t)row * DM + col0;
                float q = 0.f;
#pragma unroll
                for (int bj = 0; bj < 2; ++bj)
#pragma unroll
                    for (int n = 0; n < 2; ++n) {
                        const f32x4 o = *(const f32x4*)(xr + bj * 128 + n * 16) + acc[ai][bj][m][n];
                        acc[ai][bj][m][n] = o;
                        q += (o[0] * o[0] + o[1] * o[1]) + (o[2] * o[2] + o[3] * o[3]);
                    }
                q += __shfl_xor(q, 16); q += __shfl_xor(q, 32);
                if (fq == 0) st_wt4(ss + (size_t)row * 32 + u.pn * 4 + wc, __float_as_uint(q));
            }
        asm volatile("s_waitcnt vmcnt(0)" ::: "memory");
        __builtin_amdgcn_s_barrier();
        if (threadIdx.x < 64) {
            if (threadIdx.x == 0) __hip_atomic_fetch_add(cnt + 64 * u.pm, 1u, __ATOMIC_RELAXED, __HIP_MEMORY_SCOPE_AGENT);
            pg8::panel_wait_wave0(cnt, u.pm, 8u);
        }
        asm volatile("" ::: "memory"); __builtin_amdgcn_s_barrier(); asm volatile("" ::: "memory");
        f32x4 gg[2][2];
#pragma unroll
        for (int bj = 0; bj < 2; ++bj)
#pragma unroll
            for (int n = 0; n < 2; ++n) gg[bj][n] = *(const f32x4*)(fng + col0 + bj * 128 + n * 16);
#pragma unroll
        for (int ai = 0; ai < 2; ++ai)
#pragma unroll
            for (int m = 0; m < 4; ++m) {
                const int row = row0 + ai * 128 + m * 16;
                const f32x4 pa = *(const f32x4*)(ss + (size_t)row * 32 + 8 * fq), pb = *(const f32x4*)(ss + (size_t)row * 32 + 8 * fq + 4);
                float sq = ((pa[0] + pa[1]) + (pa[2] + pa[3])) + ((pb[0] + pb[1]) + (pb[2] + pb[3]));
                sq += __shfl_xor(sq, 16); sq += __shfl_xor(sq, 32);
                const float rinv = __builtin_amdgcn_rsqf(sq * (1.0f / DM) + 1e-6f);
                float* orow = oy + (size_t)row * DM + col0;
#pragma unroll
                for (int bj = 0; bj < 2; ++bj)
#pragma unroll
                    for (int n = 0; n < 2; ++n) *(f32x4*)(orow + bj * 128 + n * 16) = acc[ai][bj][m][n] * rinv * gg[bj][n];
            }
    }
};
struct EpiG3 {
    static constexpr bool PERM = true;
    bf16_t* rb; const float* ss1; float* out;
    __device__ __forceinline__ void operator()(const f32x4 (&acc)[2][2][4][2], const pg8::Unit& u, int wr, int wc, int fr, int fq) const {
        const int t = u.pn >> 3;
        bf16_t* base = rb + (size_t)t * SZ_D;
        const int row0 = u.pm * 256 + wr * 64 + fr, col0 = (u.pn & 7) * 256 + wc * 32 + 8 * fq;
#pragma unroll
        for (int ai = 0; ai < 2; ++ai)
#pragma unroll
            for (int m = 0; m < 4; ++m) {
                const int row = row0 + ai * 128 + m * 16;
                const f32x4 pa = *(const f32x4*)(ss1 + (size_t)row * 32 + 8 * fq), pb = *(const f32x4*)(ss1 + (size_t)row * 32 + 8 * fq + 4);
                float s = ((pa[0] + pa[1]) + (pa[2] + pa[3])) + ((pb[0] + pb[1]) + (pb[2] + pb[3]));
                s += __shfl_xor(s, 16); s += __shfl_xor(s, 32);
                float rinv = __builtin_amdgcn_rsqf(s * (1.0f / DM) + 1e-6f);
                if (t == 0) rinv *= 0.08838834764831845f * 1.4426950408889634f;
                bf16_t* rowp = base + (size_t)row * DM + col0;
                float* fo = nullptr;
                if (t == 1) fo = out + (row < MP ? O_KP + (size_t)row * DM : O_KS + (size_t)(row - MP) * DM) + col0;
                if (t == 2) fo = out + (row < MP ? O_VP + (size_t)row * DM : O_VS + (size_t)(row - MP) * DM) + col0;
#pragma unroll
                for (int bj = 0; bj < 2; ++bj) {
                    f32x4 v0 = acc[ai][bj][m][0] * rinv, v1 = acc[ai][bj][m][1] * rinv;
                    if (t == 3) {
                        const f32x2 a = silu2((f32x2){v0[0], v0[1]}), b = silu2((f32x2){v0[2], v0[3]}), c = silu2((f32x2){v1[0], v1[1]}), d = silu2((f32x2){v1[2], v1[3]});
                        v0 = (f32x4){a.x, a.y, b.x, b.y}; v1 = (f32x4){c.x, c.y, d.x, d.y};
                    }
                    if (t == 1 || t == 2) { *(f32x4*)(fo + bj * 128) = v0; *(f32x4*)(fo + bj * 128 + 4) = v1; }
                    u32x4 w; w.x = cvt_pk_bf16(v0[0], v0[1]); w.y = cvt_pk_bf16(v0[2], v0[3]); w.z = cvt_pk_bf16(v1[0], v1[1]); w.w = cvt_pk_bf16(v1[2], v1[3]);
                    st_wt16(rowp + bj * 128, w);
                }
            }
    }
};

__device__ __forceinline__ void p0_transpose_item(const float* W, int K, int N, bf16_t* WT, const float* gk, LAS float* scr, int item, int lane, bool w1map) {
    const int nblk = N / 32, kb = item / nblk, nb = item % nblk, k0 = 64 * kb, n0 = 32 * nb;
    int nd0 = n0;
    if (w1map) { if (n0 < GW) nd0 = (n0 >> 7) * 256 + (n0 & 127); else if (n0 < 2 * GW) nd0 = 2 * GW + (n0 - GW); else { const int c = n0 - 2 * GW; nd0 = (c >> 7) * 256 + 128 + (c & 127); } }
    float wv[32];
#pragma unroll
    for (int i = 0; i < 32; ++i) wv[i] = W[(size_t)(k0 + 2 * i + (lane >> 5)) * N + n0 + (lane & 31)];
    if (gk) {
#pragma unroll
        for (int i = 0; i < 32; ++i) wv[i] *= gk[k0 + 2 * i + (lane >> 5)];
    }
#pragma unroll
    for (int i = 0; i < 32; ++i) scr[(2 * i + (lane >> 5)) * 33 + (lane & 31)] = wv[i];
    asm volatile("s_waitcnt lgkmcnt(0)" ::: "memory");
    const int c = lane & 7;
#pragma unroll
    for (int j = 0; j < 4; ++j) { const int n = (lane >> 3) + 8 * j; const LAS float* s = scr + (8 * c) * 33 + n;
        u32x4 o; o.x = cvt_pk_bf16(s[0 * 33], s[1 * 33]); o.y = cvt_pk_bf16(s[2 * 33], s[3 * 33]); o.z = cvt_pk_bf16(s[4 * 33], s[5 * 33]); o.w = cvt_pk_bf16(s[6 * 33], s[7 * 33]);
        *(u32x4*)(WT + (size_t)(nd0 + n) * K + k0 + 8 * c) = o; }
    asm volatile("s_waitcnt lgkmcnt(0)" ::: "memory");
}
__device__ __forceinline__ void p0_prologue(const Params& p, LAS unsigned char* lds, int G) {
    int tid_ = threadIdx.x; asm volatile("" : "+v"(tid_)); const int tid = tid_, lane = tid & 63, wave = tid >> 6;
    LAS float* scr = (LAS float*)(lds + wave * 16384);
    const int gw = blockIdx.x * 8 + wave, NGW = G * 8;
    bf16_t* W1T = (bf16_t*)(p.ws + WS_W1T); bf16_t* W2T = (bf16_t*)(p.ws + WS_W2T); bf16_t* W3T = (bf16_t*)(p.ws + WS_W3T); bf16_t* W4T = (bf16_t*)(p.ws + WS_W4T);
    constexpr int I1 = (DM / 64) * (N1 / 32), I2 = (GW / 64) * (DM / 32), I3 = (DM / 64) * (N3 / 32), I4 = (DM / 64) * (DM / 32);
    bf16_t* h0 = (bf16_t*)(p.ws + WS_RA);
    for (int m = gw; m < MT; m += NGW) {
        const float* xrow = (m < MP) ? p.xp + (size_t)m * DM : p.xs + (size_t)(m - MP) * DM;
        f32x4 v[8]; float s = 0.f;
#pragma unroll
        for (int j = 0; j < 8; ++j) { v[j] = *(const f32x4*)(xrow + 4 * lane + 256 * j); s += (v[j][0] * v[j][0] + v[j][1] * v[j][1]) + (v[j][2] * v[j][2] + v[j][3] * v[j][3]); }
        const float rinv = __builtin_amdgcn_rsqf(wave_sum(s) * (1.0f / DM) + 1e-6f);
#pragma unroll
        for (int j = 0; j < 8; ++j) { const f32x4 gg = *(const f32x4*)(p.norm_g + 4 * lane + 256 * j);
            u32x2 w; w.x = cvt_pk_bf16(v[j][0] * rinv * gg[0], v[j][1] * rinv * gg[1]); w.y = cvt_pk_bf16(v[j][2] * rinv * gg[2], v[j][3] * rinv * gg[3]);
            *(u32x2*)(h0 + (size_t)m * DM + 4 * lane + 256 * j) = w; }
    }
    for (int it = gw; it < I1 + I2 + I3 + I4; it += NGW) {
        int r = it;
        if (r < I1) { p0_transpose_item(p.w1, DM, N1, W1T, nullptr, scr, r, lane, true); continue; } r -= I1;
        if (r < I2) { p0_transpose_item(p.w2, GW, DM, W2T, nullptr, scr, r, lane, false); continue; } r -= I2;
        if (r < I3) { p0_transpose_item(p.w3, DM, N3, W3T, p.norm_g + DM, scr, r, lane, false); continue; } r -= I3;
        p0_transpose_item(p.w4, DM, DM, W4T, nullptr, scr, r, lane, false);
    }
}

constexpr int MIX_WP = 136, MIX_VP = 264;
constexpr int MIX_W_OFF = 0, MIX_V_OFF = 128 * MIX_WP * 2, MIX_ST_OFF = MIX_V_OFF + 128 * MIX_VP * 2;
__device__ __forceinline__ void mix_phase(const Params& p, LAS unsigned char* lds, int G, bool dry) {
    int tid_ = threadIdx.x; asm volatile("" : "+v"(tid_)); const int tid = tid_, wid = tid >> 6, lane = tid & 63, wr = wid >> 2, wc = wid & 3, fr = lane & 15, fq = lane >> 4;
    bf16_t* gu = (bf16_t*)(p.ws + WS_RB); const bf16_t* gv = gu + SZ_G;
    const f32x2* lnp = (const f32x2*)(p.ws + WS_LNP);
    LAS bf16_t* Wl = (LAS bf16_t*)(lds + MIX_W_OFF); LAS bf16_t* Vl = (LAS bf16_t*)(lds + MIX_V_OFF); LAS float* st = (LAS float*)(lds + MIX_ST_OFF);
    unsigned* ctr = (unsigned*)(p.ws + WS_CTL) + 2; unsigned* pcnt = (unsigned*)(p.ws + WS_CTL) + 11264;
    volatile LAS int* misc = (volatile LAS int*)(lds + MIX_ST_OFF + 1024);
    unsigned long long seen = 0ull;
    if (tid == 0) misc[0] = (int)atomicAdd(ctr, 1u);
    for (;;) {
        __syncthreads();
        const int unit = misc[0];
        if (unit >= 66 * 16) break;
        const int nb = unit >> 4, g = unit & 15, row_base = nb * 128; const bool smp = nb >= 64;
        if (!((seen >> (nb >> 1)) & 1ull)) {
            if (tid < 64) pg8::panel_wait_wave0(pcnt, nb >> 1, 48u);
            seen |= 1ull << (nb >> 1);
        }
        __syncthreads();
        int nticket = 0;
        if (tid == 0) nticket = (int)atomicAdd(ctr, 1u);
        u32x4 raw[8];
#pragma unroll
        for (int i = 0; i < 8; ++i) { const int cid = tid + 512 * i, s = cid >> 5, c = (cid & 31) * 8; raw[i] = *(const u32x4*)(gv + (size_t)(row_base + s) * GW + g * 256 + c); }
        const int t = tid >> 2, s0 = (tid & 3) * 32; bool on; const float* src;
        if (smp) { on = (t >> 5) == (tid & 3); src = p.wsp + ((size_t)g * 128 + (t & 31)) * 128; }
        else { on = (s0 >> 6) <= (t >> 6); src = p.wsp + ((size_t)g * 128 + t) * 128 + s0; }
        f32x4 wa[8];
#pragma unroll
        for (int j = 0; j < 8; ++j) wa[j] = on ? *(const f32x4*)(src + 4 * j) : (f32x4){0.f, 0.f, 0.f, 0.f};
        float ssum = 0.f, qsum = 0.f;
        {   const f32x4* pp = (const f32x4*)(lnp + (size_t)(row_base + t) * 16) + (tid & 3) * 2;
#pragma unroll
            for (int i = 0; i < 2; ++i) { const f32x4 a = pp[i]; ssum += a[0] + a[2]; qsum += a[1] + a[3]; } }
        const int cc = g * 256 + (tid & 31) * 8;
        const f32x4 g0 = *(const f32x4*)(p.lng + cc), g1 = *(const f32x4*)(p.lng + cc + 4), b0 = *(const f32x4*)(p.lnb + cc), b1 = *(const f32x4*)(p.lnb + cc + 4);
        ssum += __shfl_xor(ssum, 1); qsum += __shfl_xor(qsum, 1); ssum += __shfl_xor(ssum, 2); qsum += __shfl_xor(qsum, 2);
        if ((tid & 3) == 0) { const float mean = ssum * (1.0f / GW), var = qsum * (1.0f / GW) - mean * mean; st[t] = mean; st[128 + t] = __builtin_amdgcn_rsqf(var + 1e-5f); }
#pragma unroll
        for (int j = 0; j < 4; ++j) { const f32x4 a = wa[2 * j], b2 = wa[2 * j + 1];
            u32x4 w; w.x = cvt_pk_bf16(a[0], a[1]); w.y = cvt_pk_bf16(a[2], a[3]); w.z = cvt_pk_bf16(b2[0], b2[1]); w.w = cvt_pk_bf16(b2[2], b2[3]);
            *(LAS u32x4*)(Wl + t * MIX_WP + s0 + 8 * j) = w; }
        __syncthreads();
#pragma unroll
        for (int i = 0; i < 8; ++i) {
            const int cid = tid + 512 * i, s = cid >> 5, c = (cid & 31) * 8;
            const float mu = st[s], rs = st[128 + s];
            f32x4 x0 = (f32x4){bf_lo(raw[i].x), bf_hi(raw[i].x), bf_lo(raw[i].y), bf_hi(raw[i].y)}, x1 = (f32x4){bf_lo(raw[i].z), bf_hi(raw[i].z), bf_lo(raw[i].w), bf_hi(raw[i].w)};
            x0 = (x0 - mu) * rs * g0 + b0; x1 = (x1 - mu) * rs * g1 + b1;
            if (smp) { float* o = p.out + O_GMV + (size_t)(row_base - MP + s) * GW + g * 256 + c; *(f32x4*)o = x0; *(f32x4*)(o + 4) = x1; }
            u32x4 w; w.x = cvt_pk_bf16(x0[0], x0[1]); w.y = cvt_pk_bf16(x0[2], x0[3]); w.z = cvt_pk_bf16(x1[0], x1[1]); w.w = cvt_pk_bf16(x1[2], x1[3]);
            *(LAS u32x4*)(Vl + s * MIX_VP + c) = w;
        }
        u32x2 ur[4][4]; float bias[4];
        bf16_t* const gup = gu + (size_t)(row_base + 64 * wr + fr) * GW + g * 256 + 64 * wc + 4 * fq;
#pragma unroll
        for (int m = 0; m < 4; ++m) {
            const int tt = 64 * wr + 16 * m + fr; bias[m] = p.bsp[g * 128 + (smp ? (tt & 31) : tt)];
#pragma unroll
            for (int n = 0; n < 4; ++n) ur[m][n] = *(const u32x2*)(gup + (size_t)m * 16 * GW + 16 * n);
        }
        __syncthreads();
        f32x4 acc[4][4];
#pragma unroll
        for (int m = 0; m < 4; ++m)
#pragma unroll
            for (int n = 0; n < 4; ++n) acc[m][n] = (f32x4){0.f, 0.f, 0.f, 0.f};
#pragma unroll
        for (int ks = 0; ks < 4; ++ks) {
            bf16x8 af[4], bfr[4];
#pragma unroll
            for (int m = 0; m < 4; ++m) af[m] = *(const LAS bf16x8*)(Wl + (64 * wr + 16 * m + fr) * MIX_WP + 32 * ks + 8 * fq);
#pragma unroll
            for (int n = 0; n < 4; ++n) {
                const LAS bf16_t* a0 = Vl + (32 * ks + 8 * fq + (fr >> 2)) * MIX_VP + 64 * wc + 16 * n + 4 * (fr & 3);
                const s16x4 lo = __builtin_amdgcn_ds_read_tr16_b64_v4i16((LAS s16x4*)a0), hi = __builtin_amdgcn_ds_read_tr16_b64_v4i16((LAS s16x4*)(a0 + 4 * MIX_VP));
                bfr[n] = (bf16x8){lo[0], lo[1], lo[2], lo[3], hi[0], hi[1], hi[2], hi[3]};
            }
#pragma unroll
            for (int m = 0; m < 4; ++m)
#pragma unroll
                for (int n = 0; n < 4; ++n) acc[m][n] = __builtin_amdgcn_mfma_f32_16x16x32_bf16(bfr[n], af[m], acc[m][n], 0, 0, 0);
        }
#pragma unroll
        for (int m = 0; m < 4; ++m) {
#pragma unroll
            for (int n = 0; n < 4; ++n) {
                const f32x4 a = acc[m][n] + bias[m]; const u32x2 u2 = ur[m][n];
                u32x2 w; w.x = cvt_pk_bf16(bf_lo(u2.x) * a[0], bf_hi(u2.x) * a[1]); w.y = cvt_pk_bf16(bf_lo(u2.y) * a[2], bf_hi(u2.y) * a[3]);
                if (!dry) *(u32x2*)(gup + (size_t)m * 16 * GW + 16 * n) = w;
            }
        }
        if (tid == 0) misc[0] = nticket;
    }
}

constexpr int AT_P = 136;
constexpr int AT_K_OFF = 0, AT_V_OFF = 64 * AT_P * 2, AT_MISC_OFF = 2 * 64 * AT_P * 2;
constexpr int AT_ITEMS = 512 + 128;
__device__ __forceinline__ void attn_phase(const Params& p, LAS unsigned char* lds, int cidx) {
    int tid_ = threadIdx.x; asm volatile("" : "+v"(tid_)); const int tid = tid_, wid = __builtin_amdgcn_readfirstlane(tid >> 6), lane = tid & 63, fr = lane & 15, fq = lane >> 4;
    const bf16_t* qb = (const bf16_t*)(p.ws + WS_RB) + 2 * SZ_D; const bf16_t* kb = qb + SZ_D; const bf16_t* vb = qb + 2 * SZ_D; const bf16_t* sz1 = qb + 3 * SZ_D; bf16_t* y1 = (bf16_t*)(p.ws + WS_W1T);
    unsigned* ctr = (unsigned*)(p.ws + WS_CTL) + cidx; unsigned* pcnt = (unsigned*)(p.ws + WS_CTL) + 8192; unsigned* g3cnt = (unsigned*)(p.ws + WS_CTL) + 20480;
    unsigned long long pseen = 0ull;
#define AT_ENSURE(pm_) do { const int _pm = (pm_); if (!((pseen >> _pm) & 1ull)) { if (tid < 64) pg8::panel_wait_wave0(g3cnt, _pm, 32u); __syncthreads(); pseen |= 1ull << _pm; } } while (0)
    LAS bf16_t* Kl = (LAS bf16_t*)(lds + AT_K_OFF); LAS bf16_t* Vl = (LAS bf16_t*)(lds + AT_V_OFF); volatile LAS int* misc = (volatile LAS int*)(lds + AT_MISC_OFF);
    int prev_pm = -1, cur_pm = -1;
    for (;;) {
        __syncthreads();
        if (tid == 0) misc[0] = (int)atomicAdd(ctr, 1u);
        __syncthreads();
        const int item = misc[0];
        if (item >= AT_ITEMS) break;
        prev_pm = cur_pm;
        const bool smp = item < 128;
        int b, h, x, kt_hi, qrow0, tpos0; size_t krow0;
        if (!smp) { const int it = item - 128; x = it >> 6; const int bh = it & 63; b = bh >> 4; h = bh & 15; kt_hi = 4 * x + 3; qrow0 = b * 2048 + x * 256 + 32 * wid; tpos0 = x * 256 + 32 * wid; krow0 = (size_t)b * 2048; cur_pm = b * 8 + x; }
        else { x = 0; const int bh = item; b = bh >> 4; h = bh & 15; kt_hi = 16; qrow0 = MP + b * 32; tpos0 = 1024; krow0 = 0; cur_pm = 32; }
        const bool active = !smp || wid == 0;
        AT_ENSURE(cur_pm);
        bf16x8 qf[2][4];
#pragma unroll
        for (int mt = 0; mt < 2; ++mt)
#pragma unroll
            for (int kk = 0; kk < 4; ++kk) qf[mt][kk] = *(const bf16x8*)(qb + (size_t)(qrow0 + 16 * mt + fr) * DM + h * 128 + 32 * kk + 8 * fq);
        f32x4 o[2][8];
#pragma unroll
        for (int mt = 0; mt < 2; ++mt)
#pragma unroll
            for (int dt = 0; dt < 8; ++dt) o[mt][dt] = (f32x4){0.f, 0.f, 0.f, 0.f};
        float C[2] = {0.f, 0.f};
        bool wdone = !active;
        if (lane == 0) misc[8 + wid] = wdone ? 1 : 0;
        f32x4 pf[2][4];
        if (!smp) {
#pragma unroll
            for (int i = 0; i < 2; ++i) { const int cid = tid + 512 * i, key = cid >> 4, d8 = (cid & 15) * 8; const size_t off = (krow0 + kt_hi * 64 + key) * DM + h * 128 + d8;
                pf[i][0] = __builtin_bit_cast(f32x4, *(const u32x4*)(kb + off)); pf[i][2] = __builtin_bit_cast(f32x4, *(const u32x4*)(vb + off)); }
        }
        for (int kt = kt_hi; kt >= 0; --kt) {
            __syncthreads();
            {
                int alld = 1;
#pragma unroll
                for (int w = 0; w < 8; ++w) alld &= misc[8 + w];
                if (alld) break;
            }
#pragma unroll
            for (int i = 0; i < 2; ++i) {
                const int cid = tid + 512 * i, key = cid >> 4, d8 = (cid & 15) * 8;
                u32x4 kwv, vwv;
                if (!smp) { kwv = __builtin_bit_cast(u32x4, pf[i][0]); vwv = __builtin_bit_cast(u32x4, pf[i][2]); }
                else if (kt == 16) {
                    if (key < 32) { const size_t off = (size_t)(MP + b * 32 + key) * DM + h * 128 + d8; kwv = *(const u32x4*)(kb + off); vwv = *(const u32x4*)(vb + off); }
                    else { kwv = (u32x4){0u, 0u, 0u, 0u}; vwv = kwv; }
                } else {
                    const f32x4 k0 = pf[i][0], k1 = pf[i][1], v0 = pf[i][2], v1 = pf[i][3];
                    kwv.x = cvt_pk_bf16(k0[0], k0[1]); kwv.y = cvt_pk_bf16(k0[2], k0[3]); kwv.z = cvt_pk_bf16(k1[0], k1[1]); kwv.w = cvt_pk_bf16(k1[2], k1[3]);
                    vwv.x = cvt_pk_bf16(v0[0], v0[1]); vwv.y = cvt_pk_bf16(v0[2], v0[3]); vwv.z = cvt_pk_bf16(v1[0], v1[1]); vwv.w = cvt_pk_bf16(v1[2], v1[3]);
                }
                *(LAS u32x4*)(Kl + key * AT_P + d8) = kwv; *(LAS u32x4*)(Vl + key * AT_P + d8) = vwv;
            }
            if (kt > 0 && !smp) AT_ENSURE(b * 8 + ((kt - 1) >> 2));
            if (kt > 0) {
#pragma unroll
                for (int i = 0; i < 2; ++i) {
                    const int cid = tid + 512 * i, key = cid >> 4, d8 = (cid & 15) * 8;
                    if (!smp) { const size_t off = (krow0 + (kt - 1) * 64 + key) * DM + h * 128 + d8; pf[i][0] = __builtin_bit_cast(f32x4, *(const u32x4*)(kb + off)); pf[i][2] = __builtin_bit_cast(f32x4, *(const u32x4*)(vb + off)); }
                    else { const size_t off = (((size_t)b * 1024 + (kt - 1) * 64 + key) * 16 + h) * 128 + d8;
                        pf[i][0] = *(const f32x4*)(p.ck + off); pf[i][1] = *(const f32x4*)(p.ck + off + 4); pf[i][2] = *(const f32x4*)(p.cv + off); pf[i][3] = *(const f32x4*)(p.cv + off + 4); }
                }
            }
            __syncthreads();
            if (!wdone && kt * 64 < tpos0 + 31) {
                f32x4 st[2][4];
#pragma unroll
                for (int mt = 0; mt < 2; ++mt)
#pragma unroll
                    for (int n = 0; n < 4; ++n) st[mt][n] = (f32x4){0.f, 0.f, 0.f, 0.f};
#pragma unroll
                for (int kk = 0; kk < 4; ++kk)
#pragma unroll
                    for (int n = 0; n < 4; ++n) {
                        const bf16x8 kf = *(const LAS bf16x8*)(Kl + (16 * (fr >> 2) + 4 * n + (fr & 3)) * AT_P + 32 * kk + 8 * fq);
                        st[0][n] = __builtin_amdgcn_mfma_f32_16x16x32_bf16(kf, qf[0][kk], st[0][n], 0, 0, 0);
                        st[1][n] = __builtin_amdgcn_mfma_f32_16x16x32_bf16(kf, qf[1][kk], st[1][n], 0, 0, 0);
                    }
                bf16x8 pb[2][2];
                {
                    const int s0 = kt * 64 + 16 * fq, tq0 = tpos0 + fr, tq1 = tpos0 + 16 + fr;
                    f32x2 run = (f32x2){0.f, 0.f};
#pragma unroll
                    for (int idx = 15; idx >= 0; --idx) {
                        const f32x2 xv = (f32x2){st[0][idx >> 2][idx & 3], st[1][idx >> 2][idx & 3]};
                        const f32x2 ax = __builtin_elementwise_abs(xv);
                        f32x2 e; e.x = __builtin_amdgcn_exp2f(-ax.x); e.y = __builtin_amdgcn_exp2f(-ax.y);
                        const f32x2 e1 = e + 1.0f;
                        f32x2 lg; lg.x = __builtin_amdgcn_logf(e1.x); lg.y = __builtin_amdgcn_logf(e1.y);
                        const f32x2 sp = __builtin_elementwise_max(xv, (f32x2){0.f, 0.f}) + lg;
                        const f32x2 lw = (xv - sp) + run;
                        st[0][idx >> 2][idx & 3] = lw.x; st[1][idx >> 2][idx & 3] = lw.y;
                        f32x2 dec; dec.x = (s0 + idx) < tq0 ? sp.x : 0.f; dec.y = (s0 + idx) < tq1 ? sp.y : 0.f;
                        run = run - dec;
                    }
                    f32x2 t16, t32, t48;
                    t16.x = __shfl(run.x, (lane + 16) & 63); t16.y = __shfl(run.y, (lane + 16) & 63);
                    t32.x = __shfl(run.x, (lane + 32) & 63); t32.y = __shfl(run.y, (lane + 32) & 63);
                    t48.x = __shfl(run.x, (lane + 48) & 63); t48.y = __shfl(run.y, (lane + 48) & 63);
                    const f32x2 z2 = (f32x2){0.f, 0.f};
                    const f32x2 higher = (fq < 3 ? t16 : z2) + (fq < 2 ? t32 : z2) + (fq < 1 ? t48 : z2);
                    const f32x2 base = (f32x2){C[0], C[1]} + higher;
                    const f32x2 tot = (run + t16) + (t32 + t48);
                    C[0] += tot.x; C[1] += tot.y;
                    float w0[16], w1[16];
#pragma unroll
                    for (int idx = 0; idx < 16; ++idx) {
                        const f32x2 a2 = (f32x2){st[0][idx >> 2][idx & 3], st[1][idx >> 2][idx & 3]} + base;
                        w0[idx] = (s0 + idx) < tq0 ? __builtin_amdgcn_exp2f(a2.x) : 0.f;
                        w1[idx] = (s0 + idx) < tq1 ? __builtin_amdgcn_exp2f(a2.y) : 0.f;
                    }
#pragma unroll
                    for (int k2 = 0; k2 < 2; ++k2) {
                        u32x4 pw; pw.x = cvt_pk_bf16(w0[8 * k2 + 0], w0[8 * k2 + 1]); pw.y = cvt_pk_bf16(w0[8 * k2 + 2], w0[8 * k2 + 3]); pw.z = cvt_pk_bf16(w0[8 * k2 + 4], w0[8 * k2 + 5]); pw.w = cvt_pk_bf16(w0[8 * k2 + 6], w0[8 * k2 + 7]);
                        pb[0][k2] = __builtin_bit_cast(bf16x8, pw);
                        u32x4 pv; pv.x = cvt_pk_bf16(w1[8 * k2 + 0], w1[8 * k2 + 1]); pv.y = cvt_pk_bf16(w1[8 * k2 + 2], w1[8 * k2 + 3]); pv.z = cvt_pk_bf16(w1[8 * k2 + 4], w1[8 * k2 + 5]); pv.w = cvt_pk_bf16(w1[8 * k2 + 6], w1[8 * k2 + 7]);
                        pb[1][k2] = __builtin_bit_cast(bf16x8, pv);
                    }
                }
#pragma unroll
                for (int k2 = 0; k2 < 2; ++k2)
#pragma unroll
                    for (int dt = 0; dt < 8; ++dt) {
                        const LAS bf16_t* a0 = Vl + (16 * fq + 8 * k2 + (fr >> 2)) * AT_P + 16 * dt + 4 * (fr & 3);
                        const s16x4 lo = __builtin_amdgcn_ds_read_tr16_b64_v4i16((LAS s16x4*)a0), hi = __builtin_amdgcn_ds_read_tr16_b64_v4i16((LAS s16x4*)(a0 + 4 * AT_P));
                        const bf16x8 vf = (bf16x8){lo[0], lo[1], lo[2], lo[3], hi[0], hi[1], hi[2], hi[3]};
                        o[0][dt] = __builtin_amdgcn_mfma_f32_16x16x32_bf16(vf, pb[0][k2], o[0][dt], 0, 0, 0);
                        o[1][dt] = __builtin_amdgcn_mfma_f32_16x16x32_bf16(vf, pb[1][k2], o[1][dt], 0, 0, 0);
                    }
                if (__builtin_amdgcn_ballot_w64(C[0] < -160.f && C[1] < -160.f) == ~0ull) { wdone = true;     if (lane == 0) misc[8 + wid] = 1; }
            }
        }
        asm volatile("s_waitcnt vmcnt(0)" ::: "memory");
        __syncthreads();
        if (tid == 0 && prev_pm >= 0) __hip_atomic_fetch_add(pcnt + 64 * prev_pm, 1u, __ATOMIC_RELAXED, __HIP_MEMORY_SCOPE_AGENT);
        if (active) {
#pragma unroll
            for (int mt = 0; mt < 2; ++mt)
#pragma unroll
                for (int dt = 0; dt < 8; ++dt) {
                    const size_t off = (size_t)(qrow0 + 16 * mt + fr) * DM + h * 128 + 16 * dt + 4 * fq;
                    const u32x2 zr = *(const u32x2*)(sz1 + off); const f32x4 a = o[mt][dt];
                    u32x2 w; w.x = cvt_pk_bf16(a[0] * bf_lo(zr.x), a[1] * bf_hi(zr.x)); w.y = cvt_pk_bf16(a[2] * bf_lo(zr.y), a[3] * bf_hi(zr.y));
                    st_wt8(y1 + off, w);
                }
        }
        if (smp) {
            asm volatile("s_waitcnt vmcnt(0)" ::: "memory");
            __syncthreads();
            if (tid == 0) __hip_atomic_fetch_add(pcnt + 64 * 32, 1u, __ATOMIC_RELAXED, __HIP_MEMORY_SCOPE_AGENT);
            cur_pm = -1;
        }
    }
    asm volatile("s_waitcnt vmcnt(0)" ::: "memory");
    __syncthreads();
    if (tid == 0 && cur_pm >= 0) __hip_atomic_fetch_add(pcnt + 64 * cur_pm, 1u, __ATOMIC_RELAXED, __HIP_MEMORY_SCOPE_AGENT);
}

#undef AT_ENSURE
__device__ __forceinline__ void final_phase(const Params& p, int G) {
    int tid_ = threadIdx.x; asm volatile("" : "+v"(tid_)); const int tid = tid_, lane = tid & 63, wave = tid >> 6;
    const float* ss2 = (const float*)(p.ws + WS_SS2);
    for (int m = blockIdx.x * 8 + wave; m < MT; m += G * 8) {
        const float s = wave_sum(lane < 32 ? ss2[(size_t)m * 32 + lane] : 0.f);
        const float rinv = __builtin_amdgcn_rsqf(s * (1.0f / DM) + 1e-6f);
        float* row = p.out + (size_t)m * DM;
#pragma unroll
        for (int j = 0; j < 8; ++j) { const f32x4 v = *(const f32x4*)(row + 4 * lane + 256 * j), gg = *(const f32x4*)(p.fng + 4 * lane + 256 * j); *(f32x4*)(row + 4 * lane + 256 * j) = v * rinv * gg; }
    }
}


#define XB_TMO      128
#define XB_XCNT(j)  (256  + 64 * (j))
#define XB_XSUB(j)  (1280 + 64 * (j))
#define XB_XGEN(j)  (2304 + 64 * (j))
#define XB_TOP      3328
#define XB_TOPGEN   3392
#define XCD_BAR_WORDS 3456
#define XB_SPIN_CAP (1u << 20)
__device__ __forceinline__ unsigned xb_ld(unsigned* p)              { return __hip_atomic_load(p, __ATOMIC_RELAXED, __HIP_MEMORY_SCOPE_AGENT); }
__device__ __forceinline__ unsigned xb_add(unsigned* p, unsigned v) { return __hip_atomic_fetch_add(p, v, __ATOMIC_RELAXED, __HIP_MEMORY_SCOPE_AGENT); }
__device__ __forceinline__ unsigned xb_xcc_id() { return (unsigned)__builtin_amdgcn_s_getreg((3 << 11) | 20) & 0xFu; }
#define XB_SPIN(cond, bar) do { unsigned _sp = 0; while (cond) { __builtin_amdgcn_s_sleep(1); \
    if ((++_sp & 255u) == 0u) { if (xb_ld(&(bar)[XB_TMO])) break; if (_sp > XB_SPIN_CAP) { atomicAdd(&(bar)[XB_TMO], 1u); break; } } } } while (0)
struct XcdBarrier { unsigned* bar; unsigned x; volatile LAS unsigned* st; };
__device__ __forceinline__ XcdBarrier xcd_barrier_post(unsigned* bar, volatile LAS unsigned* st) {
    XcdBarrier b; b.bar = bar; b.x = xb_xcc_id(); b.st = st;
    if (threadIdx.x == 0) (void)xb_add(&bar[XB_XCNT(b.x)], 1u);
    return b;
}
__device__ __forceinline__ void xcd_barrier_complete(unsigned* bar, unsigned x, unsigned& nloc, unsigned& nx) {
    const unsigned G = gridDim.x * gridDim.y * gridDim.z;
    unsigned sum, cnt, mine, sp = 0u;
    for (;;) {
        sum = 0u; cnt = 0u; mine = 0u;
#pragma unroll
        for (unsigned j = 0; j < 16; ++j) { const unsigned c = xb_ld(&bar[XB_XCNT(j)]); sum += c; cnt += (c > 0u) ? 1u : 0u; mine = (j == x) ? c : mine; }
        if (sum == G) break;
        __builtin_amdgcn_s_sleep(1);
        if ((++sp & 255u) == 0u) { if (xb_ld(&bar[XB_TMO])) break; if (sp > XB_SPIN_CAP) { atomicAdd(&bar[XB_TMO], 1u); break; } }
    }
    nloc = mine > 0u ? mine : 1u; nx = cnt > 0u ? cnt : 1u;
}
__device__ __forceinline__ void xcd_barrier(const XcdBarrier& b) {
    asm volatile("s_waitcnt vmcnt(0)" ::: "memory");
    __syncthreads();
    if (threadIdx.x == 0) {
        unsigned* bar = b.bar;
        __builtin_amdgcn_s_waitcnt(0);
        unsigned nloc = b.st[0], nx = b.st[1];
        if (nloc == 0u) { xcd_barrier_complete(bar, b.x, nloc, nx); b.st[0] = nloc; b.st[1] = nx; }
        const unsigned old = xb_add(&bar[XB_XSUB(b.x)], 1u);
        const unsigned gen = old / nloc;
        if (old + 1u == (gen + 1u) * nloc) {
            __builtin_amdgcn_fence(__ATOMIC_RELEASE, "agent");
            asm volatile("s_waitcnt vmcnt(0)" ::: "memory");
            const unsigned og = xb_add(&bar[XB_TOP], 1u);
            const unsigned tg = og / nx;
            if (og + 1u == (tg + 1u) * nx) xb_add(&bar[XB_TOPGEN], 1u);
            else XB_SPIN(xb_ld(&bar[XB_TOPGEN]) == tg, bar);
            __builtin_amdgcn_fence(__ATOMIC_ACQUIRE, "agent");
            xb_add(&bar[XB_XGEN(b.x)], 1u);
            asm volatile("s_waitcnt vmcnt(0)" ::: "memory");
        } else {
            XB_SPIN(xb_ld(&bar[XB_XGEN(b.x)]) == gen, bar);
            __builtin_amdgcn_fence(__ATOMIC_ACQUIRE, "agent");
            asm volatile("s_waitcnt vmcnt(0)" ::: "memory");
        }
    }
    __syncthreads();
}

#ifndef DUP
#define DUP 0
#endif
constexpr int LDS_BYTES = 131072 + 4096 + 8192;
__global__ void __launch_bounds__(512, 2) fwd_megakernel(Params p) {
    extern __shared__ __attribute__((aligned(16))) unsigned char lds_raw[];
    LAS unsigned char* lds = (LAS unsigned char*)lds_raw;
    cg::grid_group grid = cg::this_grid();
    const int G = gridDim.x;
    bf16_t* RA = (bf16_t*)(p.ws + WS_RA); bf16_t* RB = (bf16_t*)(p.ws + WS_RB);
    volatile LAS unsigned* xst = (volatile LAS unsigned*)(lds + 131072 + 2048);
    if (threadIdx.x < 4) xst[threadIdx.x] = 0u;
    __syncthreads();
    const XcdBarrier xbar = xcd_barrier_post((unsigned*)(p.ws + WS_CTL) + 1024, xst);
    p0_prologue(p, lds, G);
    if (DUP == 1) { __syncthreads(); p0_prologue(p, lds, G); }
    if (p.ws == nullptr) grid.sync();
    xcd_barrier(xbar);
    {
        pg8::Gemm g{RA, (const bf16_t*)(p.ws + WS_W1T), MT, N1, DM}; pg8::OrderG1 S; S.init(G, (int)blockIdx.x, (unsigned*)(p.ws + WS_CTL) + 11264);
        EpiG1 E{RB, (f32x2*)(p.ws + WS_LNP), (LAS f32x2*)(lds + 131072 + 4096)};
        pg8::gemm_phase<EpiG1, pg8::OrderG1>(lds, g, S, E);
    }
    mix_phase(p, lds, G, false);
    xcd_barrier(xbar);
    {
        unsigned* cnt = (unsigned*)(p.ws + WS_CTL) + 5120;
        {
            pg8::Gemm g{RB, (const bf16_t*)(p.ws + WS_W2T), MT, DM, GW}; pg8::OrderG2 S; S.init(G, (int)blockIdx.x, cnt);
            EpiRes<true> E{p.xp, p.xs, p.out, RA, (float*)(p.ws + WS_SS1)};
            pg8::gemm_phase<EpiRes<true>, pg8::OrderG2>(lds, g, S, E);
        }
        {
            pg8::Gemm g{RA, (const bf16_t*)(p.ws + WS_W3T), MT, N3, DM}; pg8::OrderG3 S; S.init(G, (int)blockIdx.x, cnt, (unsigned*)(p.ws + WS_CTL) + 20480);
            EpiG3 E{RB + 2 * SZ_D, (const float*)(p.ws + WS_SS1), p.out};
            pg8::gemm_phase<EpiG3, pg8::OrderG3>(lds, g, S, E);
        }
    }
    if (!(G == 256 && blockIdx.x < 8)) attn_phase(p, lds, 0);
    if (G == 256) {
        pg8::Gemm g{(const bf16_t*)(p.ws + WS_W1T), (const bf16_t*)(p.ws + WS_W4T), MT, DM, DM}; pg8::OrderG4 S; S.init(G, (int)blockIdx.x, (unsigned*)(p.ws + WS_CTL) + 8192);
        EpiFinal E{p.out, (float*)(p.ws + WS_SS2), p.fng, (unsigned*)(p.ws + WS_CTL) + 14336};
        pg8::gemm_phase<EpiFinal, pg8::OrderG4>(lds, g, S, E);
        return;
    }
    {
        pg8::Gemm g{(const bf16_t*)(p.ws + WS_W1T), (const bf16_t*)(p.ws + WS_W4T), MT, DM, DM}; pg8::OrderG4 S; S.init(G, (int)blockIdx.x, (unsigned*)(p.ws + WS_CTL) + 8192);
        EpiRes<false> E{nullptr, nullptr, p.out, nullptr, (float*)(p.ws + WS_SS2)};
        pg8::gemm_phase<EpiRes<false>, pg8::OrderG4>(lds, g, S, E);
    }
    xcd_barrier(xbar);
    final_phase(p, G);
}

extern "C" void kernel_launch(void* const* d_in, const int* in_sizes, int n_in, void* d_out, int out_size, void* d_ws, size_t ws_size, hipStream_t stream) {
    static int grid_blocks = 0;
    if (!grid_blocks) {
        int dev = 0, cus = 0, per_cu = 0;
        (void)hipGetDevice(&dev);
        (void)hipDeviceGetAttribute(&cus, hipDeviceAttributeMultiprocessorCount, dev);
        (void)hipFuncSetAttribute((const void*)fwd_megakernel, hipFuncAttributeMaxDynamicSharedMemorySize, LDS_BYTES);
        (void)hipOccupancyMaxActiveBlocksPerMultiprocessor(&per_cu, (const void*)fwd_megakernel, 512, LDS_BYTES);
        if (per_cu < 1) per_cu = 1;
        grid_blocks = cus * per_cu;
        if (ws_size < 348 * MiB) fprintf(stderr, "kernel_launch: workspace too small: %zu\n", ws_size);
    }
    (void)hipMemsetAsync((char*)d_ws + WS_CTL, 0, 131072, stream);
    Params p{};
    p.xp = (const float*)d_in[0]; p.xs = (const float*)d_in[1]; p.ck = (const float*)d_in[2]; p.cv = (const float*)d_in[3]; p.norm_g = (const float*)d_in[4]; p.fng = (const float*)d_in[5];
    p.w1 = (const float*)d_in[6]; p.lng = (const float*)d_in[7]; p.lnb = (const float*)d_in[8]; p.wsp = (const float*)d_in[9]; p.bsp = (const float*)d_in[10]; p.w2 = (const float*)d_in[11];
    p.w3 = (const float*)d_in[12]; p.w4 = (const float*)d_in[13]; p.out = (float*)d_out; p.ws = (unsigned char*)d_ws;
    void* args[] = {&p};
    hipError_t e = hipLaunchCooperativeKernel((void*)fwd_megakernel, dim3(grid_blocks), dim3(512), args, LDS_BYTES, stream);
    if (e != hipSuccess) fprintf(stderr, "cooperative launch failed: %s (grid %d)\n", hipGetErrorString(e), grid_blocks);
}
```

```cpp
#include <hip/hip_runtime.h>
#include <hip/hip_cooperative_groups.h>
#include <cstdio>
#include <cstdint>
namespace cg = cooperative_groups;

#define LAS __attribute__((address_space(3)))
typedef unsigned short bf16_t;
typedef short bf16x8 __attribute__((ext_vector_type(8)));
typedef short s16x4 __attribute__((ext_vector_type(4)));
typedef float f32x4 __attribute__((ext_vector_type(4)));
typedef float f32x2 __attribute__((ext_vector_type(2)));
typedef unsigned u32x4 __attribute__((ext_vector_type(4)));
typedef unsigned u32x2 __attribute__((ext_vector_type(2)));

constexpr int DM = 2048, MP = 8192, MS = 256, MT = MP + MS;
constexpr int GW = 4096, N1 = 3 * GW, N3 = 4 * DM;
constexpr size_t MiB = 1u << 20;
constexpr size_t WS_CTL = 0;
constexpr size_t WS_W1T = 4 * MiB, WS_W2T = 52 * MiB, WS_W3T = 68 * MiB, WS_W4T = 100 * MiB;
constexpr size_t WS_RA = 108 * MiB;
constexpr size_t WS_RB = 141 * MiB;
constexpr size_t WS_LNP = 339 * MiB;
constexpr size_t WS_SS1 = 344 * MiB;
constexpr size_t WS_SS2 = 346 * MiB;
constexpr size_t SZ_G = (size_t)MT * GW;
constexpr size_t SZ_D = (size_t)MT * DM;
constexpr size_t O_YP = 0, O_YS = (size_t)MP * DM, O_KP = O_YS + (size_t)MS * DM, O_VP = O_KP + (size_t)MP * DM, O_KS = O_VP + (size_t)MP * DM, O_VS = O_KS + (size_t)MS * DM, O_GMV = O_VS + (size_t)MS * DM;

struct Params {
    const float* xp; const float* xs; const float* ck; const float* cv; const float* norm_g; const float* fng;
    const float* w1; const float* lng; const float* lnb; const float* wsp; const float* bsp; const float* w2; const float* w3; const float* w4;
    float* out; unsigned char* ws;
};

__device__ __forceinline__ unsigned cvt_pk_bf16(float lo, float hi) { unsigned r; asm volatile("v_cvt_pk_bf16_f32 %0, %1, %2" : "=v"(r) : "v"(lo), "v"(hi)); return r; }
__device__ __forceinline__ void st_wt16(void* ptr, u32x4 v) { asm volatile("global_store_dwordx4 %0, %1, off sc1\n\ts_nop 1" :: "v"(ptr), "v"(v) : "memory"); }
__device__ __forceinline__ void st_wt8(void* ptr, u32x2 v) { asm volatile("global_store_dwordx2 %0, %1, off sc1" :: "v"(ptr), "v"(v) : "memory"); }
__device__ __forceinline__ void st_wt4(void* ptr, unsigned v) { asm volatile("global_store_dword %0, %1, off sc1" :: "v"(ptr), "v"(v) : "memory"); }
__device__ __forceinline__ float bf_lo(unsigned w) { return __uint_as_float(w << 16); }
__device__ __forceinline__ float bf_hi(unsigned w) { return __uint_as_float(w & 0xffff0000u); }
__device__ __forceinline__ float fast_sigmoid_mul(float x, float arg) { return x * __builtin_amdgcn_rcpf(1.0f + __builtin_amdgcn_exp2f(-1.4426950408889634f * arg)); }
__device__ __forceinline__ float gelu_tanh(float x) { return fast_sigmoid_mul(x, x * (1.5957691216057308f + 0.07135481627260025f * x * x)); }
__device__ __forceinline__ float silu(float x) { return fast_sigmoid_mul(x, x); }
__device__ __forceinline__ f32x2 exp2_2(f32x2 a) { f32x2 r; r.x = __builtin_amdgcn_exp2f(a.x); r.y = __builtin_amdgcn_exp2f(a.y); return r; }
__device__ __forceinline__ f32x2 rcp_2(f32x2 a) { f32x2 r; r.x = __builtin_amdgcn_rcpf(a.x); r.y = __builtin_amdgcn_rcpf(a.y); return r; }
__device__ __forceinline__ f32x2 gelu_den2(f32x2 x) { return exp2_2(x * ((x * x) * (-0.10294324f) + (-2.3022082f))) + 1.0f; }
__device__ __forceinline__ f32x2 silu_den2(f32x2 x) { return exp2_2(x * (-1.4426950408889634f)) + 1.0f; }
__device__ __forceinline__ f32x2 gelu2(f32x2 x) { return x * rcp_2(gelu_den2(x)); }
__device__ __forceinline__ f32x2 silu2(f32x2 x) { return x * rcp_2(silu_den2(x)); }
__device__ __forceinline__ f32x2 guz2(f32x2 u, f32x2 z) { return (u * z) * rcp_2(gelu_den2(u) * silu_den2(z)); }
__device__ __forceinline__ float wave_sum(float v) {
#pragma unroll
    for (int o = 1; o < 64; o <<= 1) v += __shfl_xor(v, o);
    return v;
}

namespace pg8 {
constexpr int BM = 256, BK = 64, HALF = 128, HTB = HALF * BK * 2, STAGE_BYTES = 8 * HTB, NXCD = 8, WGM = 8;
__host__ __device__ __forceinline__ int lds_byte(int r, int c) { const int st = (r >> 4) * 2 + (c >> 5), rr = r & 15, cc = c & 31, ob = rr * 64 + cc * 2; return st * 1024 + (ob ^ (((ob >> 9) & 1) << 5)); }
__host__ __device__ __forceinline__ void stage_rc(int b, int& R, int& C) { const int st = b / 1024, sb = b % 1024, swz = sb ^ (((sb >> 9) & 1) << 5); R = (st >> 1) * 16 + swz / 64; C = (st & 1) * 32 + (swz % 64) / 2; }
__host__ __device__ __forceinline__ int perm32(int rho) { const int n = rho >> 4, i = rho & 15; return 8 * (i >> 2) + 4 * n + (i & 3); }
struct Unit { int pm, pn; };
struct Gemm { const bf16_t* A; const bf16_t* Bt; int M, N, K; };
struct StaticOrder {
    static constexpr bool PUBLISH = false; unsigned* cnt = nullptr; unsigned* pub = nullptr;
    int nM, nN, nwg, G, c;
    __host__ __device__ void init(int M, int N, int G_, int c_) { nM = M / BM; nN = N / BM; nwg = nM * nN; G = G_; c = c_; }
    __host__ __device__ bool next(int i, Unit& u) const {
        const long L = (long)i * G + c; if (L >= nwg) return false;
        int wgid = (int)L; { const int q = nwg / NXCD, r = nwg % NXCD, xcd = wgid % NXCD, off = wgid / NXCD; wgid = (xcd < r ? xcd * (q + 1) : r * (q + 1) + (xcd - r) * q) + off; }
        const int nig = WGM * nN, gid = wgid / nig, fm = gid * WGM, gsz = (nM - fm) < WGM ? (nM - fm) : WGM;
        u.pm = fm + ((wgid % nig) % gsz); u.pn = (wgid % nig) / gsz; return true;
    }
    __device__ __forceinline__ void a_ready(const Unit&) const {}
    __device__ __forceinline__ void done(const Unit&) const {}
};
__device__ __forceinline__ void panel_publish(unsigned* cnt, int pm) {
    asm volatile("s_waitcnt vmcnt(0)" ::: "memory");
    __builtin_amdgcn_s_barrier();
    if (threadIdx.x < 64) {
        __builtin_amdgcn_fence(__ATOMIC_RELEASE, "agent");
        asm volatile("s_waitcnt vmcnt(0)" ::: "memory");
        if (threadIdx.x == 0) __hip_atomic_fetch_add(cnt + 64 * pm, 1u, __ATOMIC_RELAXED, __HIP_MEMORY_SCOPE_AGENT);
    }
}
__device__ __forceinline__ void panel_publish_wt(unsigned* cnt, int pm) {
    asm volatile("s_waitcnt vmcnt(0)" ::: "memory");
    __builtin_amdgcn_s_barrier();
    if (threadIdx.x == 0) __hip_atomic_fetch_add(cnt + 64 * pm, 1u, __ATOMIC_RELAXED, __HIP_MEMORY_SCOPE_AGENT);
}
__device__ __forceinline__ void panel_wait_wave0(unsigned* cnt, int pm, unsigned need) {
    unsigned polls = 0;
    while ((unsigned)__builtin_amdgcn_readfirstlane(__hip_atomic_load(cnt + 64 * pm, __ATOMIC_RELAXED, __HIP_MEMORY_SCOPE_AGENT)) < need) {
        __builtin_amdgcn_s_sleep(2);
        if (++polls > (1u << 22)) break;
    }
    __builtin_amdgcn_fence(__ATOMIC_ACQUIRE, "agent");
    asm volatile("s_waitcnt vmcnt(0)" ::: "memory");
}
struct OrderG1 {
    static constexpr bool PUBLISH = true;
    StaticOrder P; unsigned* cnt; unsigned* pub; int G, c;
    __device__ void init(int G_, int c_, unsigned* cnt_) { P.init(8192, 12288, G_, c_); G = G_; c = c_; cnt = cnt_; pub = cnt_; }
    __device__ bool next(int i, Unit& u) const { const int L = i * G + c; if (L < 1536) return P.next(i, u); if (L < 1584) { u.pm = 32; u.pn = L - 1536; return true; } return false; }
    __device__ __forceinline__ void a_ready(const Unit&) const {}
    __device__ __forceinline__ void done(const Unit& u) const { panel_publish_wt(cnt, u.pm); }
};
struct OrderG2 {
    static constexpr bool PUBLISH = true;
    StaticOrder P; unsigned* cnt; unsigned* pub; int G, c;
    __device__ void init(int G_, int c_, unsigned* cnt_) { P.init(8192, 2048, G_, c_); G = G_; c = c_; cnt = cnt_; pub = cnt_; }
    __device__ bool next(int i, Unit& u) const { const int L = i * G + c; if (L < 256) return P.next(i, u); if (L < 264) { u.pm = 32; u.pn = L - 256; return true; } return false; }
    __device__ __forceinline__ void a_ready(const Unit&) const {}
    __device__ __forceinline__ void done(const Unit& u) const { panel_publish_wt(cnt, u.pm); }
};
struct OrderG3 {
    static constexpr bool PUBLISH = true;
    StaticOrder P; unsigned* cnt; unsigned* pub; int G, c;
    __device__ void init(int G_, int c_, unsigned* cnt_, unsigned* pub_) { P.init(8192, 8192, G_, c_); G = G_; c = c_; cnt = cnt_; pub = pub_; }
    __device__ bool next(int i, Unit& u) const {
        if (G == 256) {
            if (i < 4) {
                if (c < 8 && i >= 2) return false;
                P.next(i, u);
                if ((u.pm & 7) == 7 && (u.pn < 4 || (u.pn >= 8 && u.pn < 16))) {
                    if (u.pn >= 8) { const int r = (u.pm >> 3) * 8 + (u.pn - 8); u.pm = 32; u.pn = r; }
                    else { const int j = (u.pm >> 3) * 4 + u.pn; StaticOrder Q = P; Q.c = j & 7; Q.next(2 + (j >> 3), u); }
                }
                return true;
            }
            if (i == 4 && c >= 8 && c < 56) { const int r = c - 8; if (r < 32) { u.pm = 8 * (r >> 3) + 7; u.pn = 8 + (r & 7); } else { const int j = r - 32; u.pm = 8 * (j >> 2) + 7; u.pn = j & 3; } return true; }
            return false;
        }
        const int L = i * G + c; if (L < 1024) return P.next(i, u); if (L < 1056) { u.pm = 32; u.pn = L - 1024; return true; } return false;
    }
    __device__ __forceinline__ void a_ready(const Unit& u) const {
        if (threadIdx.x < 64) panel_wait_wave0(cnt, u.pm, 8u);
        asm volatile("" ::: "memory"); __builtin_amdgcn_s_barrier(); asm volatile("" ::: "memory");
    }
    __device__ __forceinline__ void done(const Unit&) const {}
};
struct OrderG4 {
    static constexpr bool PUBLISH = false;
    StaticOrder P; unsigned* cnt; unsigned* pub = nullptr; int G, c;
    __device__ void init(int G_, int c_, unsigned* cnt_) { P.init(8192, 2048, G_, c_); G = G_; c = c_; cnt = cnt_; }
    __device__ bool next(int i, Unit& u) const {
        if (G == 256) { if (c < 8) { if (i == 0) { u.pm = 32; u.pn = c; return true; } return i == 1 ? P.next(0, u) : false; } return i == 0 ? P.next(0, u) : false; }
        const int L = i * G + c; if (L < 256) return P.next(i, u); if (L < 264) { u.pm = 32; u.pn = L - 256; return true; } return false;
    }
    __device__ __forceinline__ void a_ready(const Unit& u) const {
        if (threadIdx.x < 64) panel_wait_wave0(cnt, u.pm, u.pm == 32 ? 128u : 16u);
        asm volatile("" ::: "memory"); __builtin_amdgcn_s_barrier(); asm volatile("" ::: "memory");
    }
    __device__ __forceinline__ void done(const Unit&) const {}
};

template <class Epi, class Sched, bool ALIGN_EPI = true>
__device__ __forceinline__ void gemm_phase(LAS unsigned char* lds, const Gemm g, const Sched& S, const Epi& E) {
    int tid_ = threadIdx.x; asm volatile("" : "+v"(tid_)); const int tid = tid_, wid = __builtin_amdgcn_readfirstlane(tid >> 6), lane = tid & 63, wr = wid >> 2, wc = wid & 3, fr = lane & 15, fq = lane >> 4;
    const int K = g.K, nt = K / BK;
    unsigned voffA[2], voffB[2];
#pragma unroll
    for (int i = 0; i < 2; ++i) { int R, C; stage_rc(tid * 16 + i * 8192, R, C); const int Rb = Epi::PERM ? ((R & ~31) + perm32(R & 31)) : R;
        voffA[i] = (unsigned)(R * K + C) * 2u; voffB[i] = (unsigned)(Rb * K + C) * 2u; }
    const size_t kstep = (size_t)(BK * 2);
    const size_t hstep = (size_t)HALF * K * 2;
    const size_t tstep = 2 * hstep;
    const unsigned ldsw = (unsigned)wid * 1024u;
    const int aoff = lds_byte(wr * 64 + fr, fq * 8), boff = lds_byte(wc * 32 + fr, fq * 8);
#define PG8_SA(b, h) (((b) * 2 + (h)) * HTB)
#define PG8_SB(b, h) ((4 + (b) * 2 + (h)) * HTB)
#define PG8_STAGE(bufoff, gbase, voff) do { _Pragma("unroll") for (int _i = 0; _i < 2; ++_i) \
        __builtin_amdgcn_global_load_lds((const unsigned*)((const char*)(gbase) + (voff)[_i]), (LAS unsigned*)(lds + (bufoff) + ldsw + _i * 8192), 16, 0, 0); } while (0)
#define PG8_LDA(dst, b, h) do { _Pragma("unroll") for (int m = 0; m < 4; ++m) _Pragma("unroll") for (int k = 0; k < 2; ++k) dst[m][k] = *(const LAS bf16x8*)(lds + PG8_SA(b, h) + aoff + m * 2048 + k * 1024); } while (0)
#define PG8_LDB(dst, b, h) do { _Pragma("unroll") for (int n = 0; n < 2; ++n) _Pragma("unroll") for (int k = 0; k < 2; ++k) dst[n][k] = *(const LAS bf16x8*)(lds + PG8_SB(b, h) + boff + n * 2048 + k * 1024); } while (0)
#define PG8_MMA(ai, bj, At, Bt) do { __builtin_amdgcn_s_setprio(1); _Pragma("unroll") for (int m = 0; m < 4; ++m) _Pragma("unroll") for (int n = 0; n < 2; ++n) _Pragma("unroll") for (int k = 0; k < 2; ++k) \
        acc[ai][bj][m][n] = __builtin_amdgcn_mfma_f32_16x16x32_bf16(Bt[n][k], At[m][k], acc[ai][bj][m][n], 0, 0, 0); __builtin_amdgcn_s_setprio(0); } while (0)
#define PG8_WAIT_V(n) asm volatile("s_waitcnt vmcnt(" #n ")" ::: "memory")
#define PG8_WAIT_L(n) asm volatile("s_waitcnt lgkmcnt(" #n ")" ::: "memory")
#define PG8_BAR __builtin_amdgcn_s_barrier()
#define PG8_SCHED __builtin_amdgcn_sched_barrier(0)
    Unit cur, nxt; int ui = 0; int pend = -1;
    if (!S.next(0, cur)) return;
    f32x4 acc[2][2][4][2];
#pragma unroll
    for (int a = 0; a < 2; ++a)
#pragma unroll
        for (int b = 0; b < 2; ++b)
#pragma unroll
            for (int m = 0; m < 4; ++m)
#pragma unroll
                for (int n = 0; n < 2; ++n) acc[a][b][m][n] = (f32x4){0.f, 0.f, 0.f, 0.f};
    bf16x8 At[4][2], B0[2][2], B1[2][2];
    const char* cA = (const char*)g.A + (size_t)cur.pm * tstep; const char* cB = (const char*)g.Bt + (size_t)cur.pn * tstep;
    S.a_ready(cur);
    PG8_STAGE(PG8_SB(0, 0), cB, voffB); PG8_STAGE(PG8_SB(0, 1), cB + hstep, voffB); PG8_STAGE(PG8_SA(0, 0), cA, voffA); PG8_STAGE(PG8_SA(0, 1), cA + hstep, voffA);
    if (wr == 1) PG8_BAR;
    PG8_WAIT_V(2); PG8_BAR;
    PG8_STAGE(PG8_SB(1, 0), cB + kstep, voffB); PG8_STAGE(PG8_SA(1, 0), cA + kstep, voffA); PG8_STAGE(PG8_SB(1, 1), cB + hstep + kstep, voffB);
    PG8_WAIT_V(6); PG8_BAR;
    for (;;) {
        const bool has_next = S.next(ui + 1, nxt);
        const char* nA = has_next ? (const char*)g.A + (size_t)nxt.pm * tstep : cA; const char* nB = has_next ? (const char*)g.Bt + (size_t)nxt.pn * tstep : cB;
        for (int t = 0; t < nt; t += 2) {
            const bool last = (t == nt - 2);
            const char* a1 = cA + (size_t)(t + 1) * kstep;
            const char* a2 = last ? nA : cA + (size_t)(t + 2) * kstep; const char* b2 = last ? nB : cB + (size_t)(t + 2) * kstep;
            const char* a3 = a2 + kstep; const char* b3 = b2 + kstep;
            if (last && has_next) S.a_ready(nxt);
            if (Sched::PUBLISH && t == 4 && pend >= 0) {
                if (tid == 0) __hip_atomic_fetch_add(S.pub + 64 * pend, 1u, __ATOMIC_RELAXED, __HIP_MEMORY_SCOPE_AGENT);
                pend = -1;
            }
            PG8_LDB(B0, 0, 0); PG8_LDB(B1, 0, 1); PG8_SCHED; PG8_LDA(At, 0, 0); PG8_STAGE(PG8_SA(1, 1), a1 + hstep, voffA);
            PG8_WAIT_V(8); PG8_WAIT_L(0); PG8_BAR; PG8_MMA(0, 0, At, B0); PG8_MMA(0, 1, At, B1); PG8_BAR; PG8_SCHED;
            PG8_LDA(At, 0, 1); PG8_STAGE(PG8_SB(0, 0), b2, voffB); PG8_STAGE(PG8_SB(0, 1), b2 + hstep, voffB); PG8_STAGE(PG8_SA(0, 0), a2, voffA);
            PG8_WAIT_V(8); PG8_WAIT_L(0); PG8_BAR; PG8_MMA(1, 0, At, B0); PG8_MMA(1, 1, At, B1); PG8_BAR; PG8_SCHED;
            PG8_LDB(B0, 1, 0); PG8_LDB(B1, 1, 1); PG8_SCHED; PG8_LDA(At, 1, 0); PG8_STAGE(PG8_SA(0, 1), a2 + hstep, voffA);
            PG8_WAIT_V(8); PG8_WAIT_L(0); PG8_BAR; PG8_MMA(0, 0, At, B0); PG8_MMA(0, 1, At, B1); PG8_BAR; PG8_SCHED;
            PG8_LDA(At, 1, 1); PG8_STAGE(PG8_SB(1, 0), b3, voffB); PG8_STAGE(PG8_SB(1, 1), b3 + hstep, voffB); PG8_STAGE(PG8_SA(1, 0), a3, voffA);
            PG8_WAIT_V(8); PG8_WAIT_L(0); PG8_BAR; PG8_MMA(1, 0, At, B0); PG8_MMA(1, 1, At, B1); PG8_BAR; PG8_SCHED;
        }
        if constexpr (ALIGN_EPI) { if (wr == 0) PG8_BAR; }
        E(acc, cur, wr, wc, fr, fq); if (Sched::PUBLISH) pend = cur.pm;
        if (!has_next) break;
#pragma unroll
        for (int a = 0; a < 2; ++a)
#pragma unroll
            for (int b = 0; b < 2; ++b)
#pragma unroll
                for (int m = 0; m < 4; ++m)
#pragma unroll
                    for (int n = 0; n < 2; ++n) acc[a][b][m][n] = (f32x4){0.f, 0.f, 0.f, 0.f};
        cur = nxt; cA = nA; cB = nB; ++ui;
        if constexpr (ALIGN_EPI) { if (wr == 1) PG8_BAR; }
    }
    PG8_WAIT_V(0);
    if constexpr (!ALIGN_EPI) { if (wr == 0) PG8_BAR; }
    PG8_BAR;
    if (Sched::PUBLISH && pend >= 0 && tid == 0) __hip_atomic_fetch_add(S.pub + 64 * pend, 1u, __ATOMIC_RELAXED, __HIP_MEMORY_SCOPE_AGENT);
#undef PG8_SA
#undef PG8_SB
#undef PG8_STAGE
#undef PG8_LDA
#undef PG8_LDB
#undef PG8_MMA
#undef PG8_WAIT_V
#undef PG8_WAIT_L
#undef PG8_BAR
#undef PG8_SCHED
}
}

struct EpiG1 {
    static constexpr bool PERM = true;
    bf16_t* rb; f32x2* lnp; LAS f32x2* red;
    __device__ __forceinline__ void operator()(const f32x4 (&acc)[2][2][4][2], const pg8::Unit& u, int wr, int wc, int fr, int fq) const {
        const int row0 = u.pm * 256 + wr * 64 + fr;
        if (u.pn < 32) {
            const int col0 = u.pn * 128 + wc * 32 + 8 * fq;
#pragma unroll
            for (int ai = 0; ai < 2; ++ai)
#pragma unroll
                for (int m = 0; m < 4; ++m) {
                    const int row = row0 + ai * 128 + m * 16;
                    const f32x4 u0 = acc[ai][0][m][0], u1 = acc[ai][0][m][1], z0 = acc[ai][1][m][0], z1 = acc[ai][1][m][1];
                    const f32x2 a = guz2((f32x2){u0[0], u0[1]}, (f32x2){z0[0], z0[1]}), b = guz2((f32x2){u0[2], u0[3]}, (f32x2){z0[2], z0[3]});
                    const f32x2 c = guz2((f32x2){u1[0], u1[1]}, (f32x2){z1[0], z1[1]}), d = guz2((f32x2){u1[2], u1[3]}, (f32x2){z1[2], z1[3]});
                    u32x4 w; w.x = cvt_pk_bf16(a.x, a.y); w.y = cvt_pk_bf16(b.x, b.y); w.z = cvt_pk_bf16(c.x, c.y); w.w = cvt_pk_bf16(d.x, d.y);
                    st_wt16(rb + (size_t)row * GW + col0, w);
                }
        } else {
            const int pv = u.pn - 32;
            bf16_t* base = rb + SZ_G;
            const int col0 = pv * 256 + wc * 32 + 8 * fq;
#pragma unroll
            for (int ai = 0; ai < 2; ++ai)
#pragma unroll
                for (int m = 0; m < 4; ++m) {
                    const int row = row0 + ai * 128 + m * 16;
                    bf16_t* rowp = base + (size_t)row * GW + col0;
                    f32x2 s2 = (f32x2){0.f, 0.f}, q2 = s2;
#pragma unroll
                    for (int bj = 0; bj < 2; ++bj) {
                        const f32x4 x0 = acc[ai][bj][m][0], x1 = acc[ai][bj][m][1];
                        const f32x2 a = gelu2((f32x2){x0[0], x0[1]}), b = gelu2((f32x2){x0[2], x0[3]}), c = gelu2((f32x2){x1[0], x1[1]}), d = gelu2((f32x2){x1[2], x1[3]});
                        s2 += (a + b) + (c + d); q2 += (a * a + b * b) + (c * c + d * d);
                        u32x4 w; w.x = cvt_pk_bf16(a.x, a.y); w.y = cvt_pk_bf16(b.x, b.y); w.z = cvt_pk_bf16(c.x, c.y); w.w = cvt_pk_bf16(d.x, d.y);
                        st_wt16(rowp + bj * 128, w);
                    }
                    float s = s2.x + s2.y, q = q2.x + q2.y;
                    s += __shfl_xor(s, 16); s += __shfl_xor(s, 32); q += __shfl_xor(q, 16); q += __shfl_xor(q, 32);
                    if (fq == 0) red[(ai * 128 + wr * 64 + m * 16 + fr) * 4 + wc] = (f32x2){s, q};
                }
            asm volatile("s_waitcnt lgkmcnt(0)" ::: "memory"); __builtin_amdgcn_s_barrier(); asm volatile("" ::: "memory");
            if (threadIdx.x < 256) {
                const int r = threadIdx.x; const f32x2 a = red[r * 4 + 0], b = red[r * 4 + 1], c = red[r * 4 + 2], d = red[r * 4 + 3];
                st_wt8(lnp + (size_t)(u.pm * 256 + r) * 16 + pv, (u32x2){__float_as_uint((a[0] + b[0]) + (c[0] + d[0])), __float_as_uint((a[1] + b[1]) + (c[1] + d[1]))});
            }
        }
    }
};
template <bool FIRST> struct EpiRes {
    static constexpr bool PERM = false;
    const float* xp; const float* xs; float* oy; bf16_t* xb; float* ss;
    __device__ __forceinline__ void operator()(const f32x4 (&acc)[2][2][4][2], const pg8::Unit& u, int wr, int wc, int fr, int fq) const {
        const int row0 = u.pm * 256 + wr * 64 + fr, col0 = u.pn * 256 + wc * 32 + 4 * fq;
#pragma unroll
        for (int ai = 0; ai < 2; ++ai)
#pragma unroll
            for (int m = 0; m < 4; ++m) {
                const int row = row0 + ai * 128 + m * 16;
                float* orow = oy + (size_t)row * DM + col0;
                const float* xr = FIRST ? ((row < MP ? xp + (size_t)row * DM : xs + (size_t)(row - MP) * DM) + col0) : orow;
                float q = 0.f;
#pragma unroll
                for (int bj = 0; bj < 2; ++bj)
#pragma unroll
                    for (int n = 0; n < 2; ++n) {
                        const f32x4 xv = *(const f32x4*)(xr + bj * 128 + n * 16);
                        const f32x4 o = xv + acc[ai][bj][m][n];
                        *(f32x4*)(orow + bj * 128 + n * 16) = o;
                        q += (o[0] * o[0] + o[1] * o[1]) + (o[2] * o[2] + o[3] * o[3]);
                        if (FIRST) { u32x2 w; w.x = cvt_pk_bf16(o[0], o[1]); w.y = cvt_pk_bf16(o[2], o[3]); st_wt8(xb + (size_t)row * DM + col0 + bj * 128 + n * 16, w); }
                    }
                q += __shfl_xor(q, 16); q += __shfl_xor(q, 32);
                if (fq == 0) { if (FIRST) st_wt4(ss + (size_t)row * 32 + u.pn * 4 + wc, __float_as_uint(q)); else ss[(size_t)row * 32 + u.pn * 4 + wc] = q; }
            }
    }
};
struct EpiFinal {
    static constexpr bool PERM = false;
    float* oy; float* ss; const float* fng; unsigned* cnt;
    __device__ __forceinline__ void operator()(f32x4 (&acc)[2][2][4][2], const pg8::Unit& u, int wr, int wc, int fr, int fq) const {
        const int row0 = u.pm * 256 + wr * 64 + fr, col0 = u.pn * 256 + wc * 32 + 4 * fq;
#pragma unroll
        for (int ai = 0; ai < 2; ++ai)
#pragma unroll
            for (int m = 0; m < 4; ++m) {
                const int row = row0 + ai * 128 + m * 16;
                const float* xr = oy + (size_t)row * DM + col0;
                float q = 0.f;
#pragma unroll
                for (int bj = 0; bj < 2; ++bj)
#pragma unroll
                    for (int n = 0; n < 2; ++n) {
                        const f32x4 o = *(const f32x4*)(xr + bj * 128 + n * 16) + acc[ai][bj][m][n];
                        acc[ai][bj][m][n] = o;
                        q += (o[0] * o[0] + o[1] * o[1]) + (o[2] * o[2] + o[3] * o[3]);
                    }
                q += __shfl_xor(q, 16); q += __shfl_xor(q, 32);
                if (fq == 0) st_wt4(ss + (size_t)row * 32 + u.pn * 4 + wc, __float_as_uint(q));
            }
        asm volatile("s_waitcnt vmcnt(0)" ::: "memory");
        __builtin_amdgcn_s_barrier();
        if (threadIdx.x < 64) {
            if (threadIdx.x == 0) __hip_atomic_fetch_add(cnt + 64 * u.pm, 1u, __ATOMIC_RELAXED, __HIP_MEMORY_SCOPE_AGENT);
            pg8::panel_wait_wave0(cnt, u.pm, 8u);
        }
        asm volatile("" ::: "memory"); __builtin_amdgcn_s_barrier(); asm volatile("" ::: "memory");
        f32x4 gg[2][2];
#pragma unroll
        for (int bj = 0; bj < 2; ++bj)
#pragma unroll
            for (int n = 0; n < 2; ++n) gg[bj][n] = *(const f32x4*)(fng + col0 + bj * 128 + n * 16);
#pragma unroll
        for (int ai = 0; ai < 2; ++ai)
#pragma unroll
            for (int m = 0; m < 4; ++m) {
                const int row = row0 + ai * 128 + m * 16;
                const f32x4 pa = *(const f32x4*)(ss + (size_t)row * 32 + 8 * fq), pb = *(const f32x4*)(ss + (size_t)row * 32 + 8 * fq + 4);
                float sq = ((pa[0] + pa[1]) + (pa[2] + pa[3])) + ((pb[0] + pb[1]) + (pb[2] + pb[3]));
                sq += __shfl_xor(sq, 16); sq += __shfl_xor(sq, 32);
                const float rinv = __builtin_amdgcn_rsqf(sq * (1.0f / DM) + 1e-6f);
                float* orow = oy + (size_t)row * DM + col0;
#pragma unroll
                for (int bj = 0; bj < 2; ++bj)
#pragma unroll
                    for (int n = 0; n < 2; ++n) *(f32x4*)(orow + bj * 128 + n * 16) = acc[ai][bj][m][n] * rinv * gg[bj][n];
            }
    }
};
struct EpiG3 {
    static constexpr bool PERM = true;
    bf16_t* rb; const float* ss1; float* out;
    __device__ __forceinline__ void operator()(const f32x4 (&acc)[2][2][4][2], const pg8::Unit& u, int wr, int wc, int fr, int fq) const {
        const int t = u.pn >> 3;
        bf16_t* base = rb + (size_t)t * SZ_D;
        const int row0 = u.pm * 256 + wr * 64 + fr, col0 = (u.pn & 7) * 256 + wc * 32 + 8 * fq;
#pragma unroll
        for (int ai = 0; ai < 2; ++ai)
#pragma unroll
            for (int m = 0; m < 4; ++m) {
                const int row = row0 + ai * 128 + m * 16;
                const f32x4 pa = *(const f32x4*)(ss1 + (size_t)row * 32 + 8 * fq), pb = *(const f32x4*)(ss1 + (size_t)row * 32 + 8 * fq + 4);
                float s = ((pa[0] + pa[1]) + (pa[2] + pa[3])) + ((pb[0] + pb[1]) + (pb[2] + pb[3]));
                s += __shfl_xor(s, 16); s += __shfl_xor(s, 32);
                float rinv = __builtin_amdgcn_rsqf(s * (1.0f / DM) + 1e-6f);
                if (t == 0) rinv *= 0.08838834764831845f * 1.4426950408889634f;
                bf16_t* rowp = base + (size_t)row * DM + col0;
                float* fo = nullptr;
                if (t == 1) fo = out + (row < MP ? O_KP + (size_t)row * DM : O_KS + (size_t)(row - MP) * DM) + col0;
                if (t == 2) fo = out + (row < MP ? O_VP + (size_t)row * DM : O_VS + (size_t)(row - MP) * DM) + col0;
#pragma unroll
                for (int bj = 0; bj < 2; ++bj) {
                    f32x4 v0 = acc[ai][bj][m][0] * rinv, v1 = acc[ai][bj][m][1] * rinv;
                    if (t == 3) {
                        const f32x2 a = silu2((f32x2){v0[0], v0[1]}), b = silu2((f32x2){v0[2], v0[3]}), c = silu2((f32x2){v1[0], v1[1]}), d = silu2((f32x2){v1[2], v1[3]});
                        v0 = (f32x4){a.x, a.y, b.x, b.y}; v1 = (f32x4){c.x, c.y, d.x, d.y};
                    }
                    if (t == 1 || t == 2) { *(f32x4*)(fo + bj * 128) = v0; *(f32x4*)(fo + bj * 128 + 4) = v1; }
                    u32x4 w; w.x = cvt_pk_bf16(v0[0], v0[1]); w.y = cvt_pk_bf16(v0[2], v0[3]); w.z = cvt_pk_bf16(v1[0], v1[1]); w.w = cvt_pk_bf16(v1[2], v1[3]);
                    st_wt16(rowp + bj * 128, w);
                }
            }
    }
};

__device__ __forceinline__ void p0_transpose_item(const float* W, int K, int N, bf16_t* WT, const float* gk, LAS float* scr, int item, int lane, bool w1map) {
    const int nblk = N / 32, kb = item / nblk, nb = item % nblk, k0 = 64 * kb, n0 = 32 * nb;
    int nd0 = n0;
    if (w1map) { if (n0 < GW) nd0 = (n0 >> 7) * 256 + (n0 & 127); else if (n0 < 2 * GW) nd0 = 2 * GW + (n0 - GW); else { const int c = n0 - 2 * GW; nd0 = (c >> 7) * 256 + 128 + (c & 127); } }
    float wv[32];
#pragma unroll
    for (int i = 0; i < 32; ++i) wv[i] = __builtin_nontemporal_load(W + (size_t)(k0 + 2 * i + (lane >> 5)) * N + n0 + (lane & 31));
    if (gk) {
#pragma unroll
        for (int i = 0; i < 32; ++i) wv[i] *= gk[k0 + 2 * i + (lane >> 5)];
    }
#pragma unroll
    for (int i = 0; i < 32; ++i) scr[(2 * i + (lane >> 5)) * 33 + (lane & 31)] = wv[i];
    asm volatile("s_waitcnt lgkmcnt(0)" ::: "memory");
    const int c = lane & 7;
#pragma unroll
    for (int j = 0; j < 4; ++j) { const int n = (lane >> 3) + 8 * j; const LAS float* s = scr + (8 * c) * 33 + n;
        u32x4 o; o.x = cvt_pk_bf16(s[0 * 33], s[1 * 33]); o.y = cvt_pk_bf16(s[2 * 33], s[3 * 33]); o.z = cvt_pk_bf16(s[4 * 33], s[5 * 33]); o.w = cvt_pk_bf16(s[6 * 33], s[7 * 33]);
        *(u32x4*)(WT + (size_t)(nd0 + n) * K + k0 + 8 * c) = o; }
    asm volatile("s_waitcnt lgkmcnt(0)" ::: "memory");
}
__device__ __forceinline__ void p0_prologue(const Params& p, LAS unsigned char* lds, int G) {
    int tid_ = threadIdx.x; asm volatile("" : "+v"(tid_)); const int tid = tid_, lane = tid & 63, wave = tid >> 6;
    LAS float* scr = (LAS float*)(lds + wave * 16384);
    const int gw = blockIdx.x * 8 + wave, NGW = G * 8;
    bf16_t* W1T = (bf16_t*)(p.ws + WS_W1T); bf16_t* W2T = (bf16_t*)(p.ws + WS_W2T); bf16_t* W3T = (bf16_t*)(p.ws + WS_W3T); bf16_t* W4T = (bf16_t*)(p.ws + WS_W4T);
    constexpr int I1 = (DM / 64) * (N1 / 32), I2 = (GW / 64) * (DM / 32), I3 = (DM / 64) * (N3 / 32), I4 = (DM / 64) * (DM / 32);
    bf16_t* h0 = (bf16_t*)(p.ws + WS_RA);
    for (int m = gw; m < MT; m += NGW) {
        const float* xrow = (m < MP) ? p.xp + (size_t)m * DM : p.xs + (size_t)(m - MP) * DM;
        f32x4 v[8]; float s = 0.f;
#pragma unroll
        for (int j = 0; j < 8; ++j) { v[j] = __builtin_nontemporal_load((const f32x4*)(xrow + 4 * lane + 256 * j)); s += (v[j][0] * v[j][0] + v[j][1] * v[j][1]) + (v[j][2] * v[j][2] + v[j][3] * v[j][3]); }
        const float rinv = __builtin_amdgcn_rsqf(wave_sum(s) * (1.0f / DM) + 1e-6f);
#pragma unroll
        for (int j = 0; j < 8; ++j) { const f32x4 gg = *(const f32x4*)(p.norm_g + 4 * lane + 256 * j);
            u32x2 w; w.x = cvt_pk_bf16(v[j][0] * rinv * gg[0], v[j][1] * rinv * gg[1]); w.y = cvt_pk_bf16(v[j][2] * rinv * gg[2], v[j][3] * rinv * gg[3]);
            *(u32x2*)(h0 + (size_t)m * DM + 4 * lane + 256 * j) = w; }
    }
    for (int it = gw; it < I1 + I2 + I3 + I4; it += NGW) {
        int r = it;
        if (r < I1) { p0_transpose_item(p.w1, DM, N1, W1T, nullptr, scr, r, lane, true); continue; } r -= I1;
        if (r < I2) { p0_transpose_item(p.w2, GW, DM, W2T, nullptr, scr, r, lane, false); continue; } r -= I2;
        if (r < I3) { p0_transpose_item(p.w3, DM, N3, W3T, p.norm_g + DM, scr, r, lane, false); continue; } r -= I3;
        p0_transpose_item(p.w4, DM, DM, W4T, nullptr, scr, r, lane, false);
    }
}

constexpr int MIX_WP = 136, MIX_VP = 264;
constexpr int MIX_W_OFF = 0, MIX_V_OFF = 128 * MIX_WP * 2, MIX_ST_OFF = MIX_V_OFF + 128 * MIX_VP * 2;
__device__ __forceinline__ void mix_phase(const Params& p, LAS unsigned char* lds, int G, bool dry) {
    int tid_ = threadIdx.x; asm volatile("" : "+v"(tid_)); const int tid = tid_, wid = tid >> 6, lane = tid & 63, wr = wid >> 2, wc = wid & 3, fr = lane & 15, fq = lane >> 4;
    bf16_t* gu = (bf16_t*)(p.ws + WS_RB); const bf16_t* gv = gu + SZ_G;
    const f32x2* lnp = (const f32x2*)(p.ws + WS_LNP);
    LAS bf16_t* Wl = (LAS bf16_t*)(lds + MIX_W_OFF); LAS bf16_t* Vl = (LAS bf16_t*)(lds + MIX_V_OFF); LAS float* st = (LAS float*)(lds + MIX_ST_OFF);
    unsigned* ctr = (unsigned*)(p.ws + WS_CTL) + 2; unsigned* pcnt = (unsigned*)(p.ws + WS_CTL) + 11264;
    volatile LAS int* misc = (volatile LAS int*)(lds + MIX_ST_OFF + 1024);
    unsigned long long seen = 0ull;
    if (tid == 0) misc[0] = (int)atomicAdd(ctr, 1u);
    for (;;) {
        __syncthreads();
        const int unit = misc[0];
        if (unit >= 66 * 16) break;
        const int nb = unit >> 4, g = unit & 15, row_base = nb * 128; const bool smp = nb >= 64;
        if (!((seen >> (nb >> 1)) & 1ull)) {
            if (tid < 64) pg8::panel_wait_wave0(pcnt, nb >> 1, 48u);
            seen |= 1ull << (nb >> 1);
        }
        __syncthreads();
        int nticket = 0;
        if (tid == 0) nticket = (int)atomicAdd(ctr, 1u);
        u32x4 raw[8];
#pragma unroll
        for (int i = 0; i < 8; ++i) { const int cid = tid + 512 * i, s = cid >> 5, c = (cid & 31) * 8; raw[i] = *(const u32x4*)(gv + (size_t)(row_base + s) * GW + g * 256 + c); }
        const int t = tid >> 2, s0 = (tid & 3) * 32; bool on; const float* src;
        if (smp) { on = (t >> 5) == (tid & 3); src = p.wsp + ((size_t)g * 128 + (t & 31)) * 128; }
        else { on = (s0 >> 6) <= (t >> 6); src = p.wsp + ((size_t)g * 128 + t) * 128 + s0; }
        f32x4 wa[8];
#pragma unroll
        for (int j = 0; j < 8; ++j) wa[j] = on ? *(const f32x4*)(src + 4 * j) : (f32x4){0.f, 0.f, 0.f, 0.f};
        float ssum = 0.f, qsum = 0.f;
        {   const f32x4* pp = (const f32x4*)(lnp + (size_t)(row_base + t) * 16) + (tid & 3) * 2;
#pragma unroll
            for (int i = 0; i < 2; ++i) { const f32x4 a = pp[i]; ssum += a[0] + a[2]; qsum += a[1] + a[3]; } }
        const int cc = g * 256 + (tid & 31) * 8;
        const f32x4 g0 = *(const f32x4*)(p.lng + cc), g1 = *(const f32x4*)(p.lng + cc + 4), b0 = *(const f32x4*)(p.lnb + cc), b1 = *(const f32x4*)(p.lnb + cc + 4);
        ssum += __shfl_xor(ssum, 1); qsum += __shfl_xor(qsum, 1); ssum += __shfl_xor(ssum, 2); qsum += __shfl_xor(qsum, 2);
        if ((tid & 3) == 0) { const float mean = ssum * (1.0f / GW), var = qsum * (1.0f / GW) - mean * mean; st[t] = mean; st[128 + t] = __builtin_amdgcn_rsqf(var + 1e-5f); }
#pragma unroll
        for (int j = 0; j < 4; ++j) { const f32x4 a = wa[2 * j], b2 = wa[2 * j + 1];
            u32x4 w; w.x = cvt_pk_bf16(a[0], a[1]); w.y = cvt_pk_bf16(a[2], a[3]); w.z = cvt_pk_bf16(b2[0], b2[1]); w.w = cvt_pk_bf16(b2[2], b2[3]);
            *(LAS u32x4*)(Wl + t * MIX_WP + s0 + 8 * j) = w; }
        __syncthreads();
#pragma unroll
        for (int i = 0; i < 8; ++i) {
            const int cid = tid + 512 * i, s = cid >> 5, c = (cid & 31) * 8;
            const float mu = st[s], rs = st[128 + s];
            f32x4 x0 = (f32x4){bf_lo(raw[i].x), bf_hi(raw[i].x), bf_lo(raw[i].y), bf_hi(raw[i].y)}, x1 = (f32x4){bf_lo(raw[i].z), bf_hi(raw[i].z), bf_lo(raw[i].w), bf_hi(raw[i].w)};
            x0 = (x0 - mu) * rs * g0 + b0; x1 = (x1 - mu) * rs * g1 + b1;
            if (smp) { float* o = p.out + O_GMV + (size_t)(row_base - MP + s) * GW + g * 256 + c; *(f32x4*)o = x0; *(f32x4*)(o + 4) = x1; }
            u32x4 w; w.x = cvt_pk_bf16(x0[0], x0[1]); w.y = cvt_pk_bf16(x0[2], x0[3]); w.z = cvt_pk_bf16(x1[0], x1[1]); w.w = cvt_pk_bf16(x1[2], x1[3]);
            *(LAS u32x4*)(Vl + s * MIX_VP + c) = w;
        }
        u32x2 ur[4][4]; float bias[4];
        bf16_t* const gup = gu + (size_t)(row_base + 64 * wr + fr) * GW + g * 256 + 64 * wc + 4 * fq;
#pragma unroll
        for (int m = 0; m < 4; ++m) {
            const int tt = 64 * wr + 16 * m + fr; bias[m] = p.bsp[g * 128 + (smp ? (tt & 31) : tt)];
#pragma unroll
            for (int n = 0; n < 4; ++n) ur[m][n] = *(const u32x2*)(gup + (size_t)m * 16 * GW + 16 * n);
        }
        __syncthreads();
        f32x4 acc[4][4];
#pragma unroll
        for (int m = 0; m < 4; ++m)
#pragma unroll
            for (int n = 0; n < 4; ++n) acc[m][n] = (f32x4){0.f, 0.f, 0.f, 0.f};
#pragma unroll
        for (int ks = 0; ks < 4; ++ks) {
            bf16x8 af[4], bfr[4];
#pragma unroll
            for (int m = 0; m < 4; ++m) af[m] = *(const LAS bf16x8*)(Wl + (64 * wr + 16 * m + fr) * MIX_WP + 32 * ks + 8 * fq);
#pragma unroll
            for (int n = 0; n < 4; ++n) {
                const LAS bf16_t* a0 = Vl + (32 * ks + 8 * fq + (fr >> 2)) * MIX_VP + 64 * wc + 16 * n + 4 * (fr & 3);
                const s16x4 lo = __builtin_amdgcn_ds_read_tr16_b64_v4i16((LAS s16x4*)a0), hi = __builtin_amdgcn_ds_read_tr16_b64_v4i16((LAS s16x4*)(a0 + 4 * MIX_VP));
                bfr[n] = (bf16x8){lo[0], lo[1], lo[2], lo[3], hi[0], hi[1], hi[2], hi[3]};
            }
#pragma unroll
            for (int m = 0; m < 4; ++m)
#pragma unroll
                for (int n = 0; n < 4; ++n) acc[m][n] = __builtin_amdgcn_mfma_f32_16x16x32_bf16(bfr[n], af[m], acc[m][n], 0, 0, 0);
        }
#pragma unroll
        for (int m = 0; m < 4; ++m) {
#pragma unroll
            for (int n = 0; n < 4; ++n) {
                const f32x4 a = acc[m][n] + bias[m]; const u32x2 u2 = ur[m][n];
                u32x2 w; w.x = cvt_pk_bf16(bf_lo(u2.x) * a[0], bf_hi(u2.x) * a[1]); w.y = cvt_pk_bf16(bf_lo(u2.y) * a[2], bf_hi(u2.y) * a[3]);
                if (!dry) *(u32x2*)(gup + (size_t)m * 16 * GW + 16 * n) = w;
            }
        }
        if (tid == 0) misc[0] = nticket;
    }
}

constexpr int AT_P = 136;
constexpr int AT_K_OFF = 0, AT_V_OFF = 64 * AT_P * 2, AT_MISC_OFF = 2 * 64 * AT_P * 2;
constexpr int AT_ITEMS = 512 + 128;
__device__ __forceinline__ void attn_phase(const Params& p, LAS unsigned char* lds, int cidx) {
    int tid_ = threadIdx.x; asm volatile("" : "+v"(tid_)); const int tid = tid_, wid = __builtin_amdgcn_readfirstlane(tid >> 6), lane = tid & 63, fr = lane & 15, fq = lane >> 4;
    const bf16_t* qb = (const bf16_t*)(p.ws + WS_RB) + 2 * SZ_D; const bf16_t* kb = qb + SZ_D; const bf16_t* vb = qb + 2 * SZ_D; const bf16_t* sz1 = qb + 3 * SZ_D; bf16_t* y1 = (bf16_t*)(p.ws + WS_W1T);
    unsigned* ctr = (unsigned*)(p.ws + WS_CTL) + cidx; unsigned* pcnt = (unsigned*)(p.ws + WS_CTL) + 8192; unsigned* g3cnt = (unsigned*)(p.ws + WS_CTL) + 20480;
    unsigned long long pseen = 0ull;
#define AT_ENSURE(pm_) do { const int _pm = (pm_); if (!((pseen >> _pm) & 1ull)) { if (tid < 64) pg8::panel_wait_wave0(g3cnt, _pm, 32u); __syncthreads(); pseen |= 1ull << _pm; } } while (0)
    LAS bf16_t* Kl = (LAS bf16_t*)(lds + AT_K_OFF); LAS bf16_t* Vl = (LAS bf16_t*)(lds + AT_V_OFF); volatile LAS int* misc = (volatile LAS int*)(lds + AT_MISC_OFF);
    int prev_pm = -1, cur_pm = -1;
    for (;;) {
        __syncthreads();
        if (tid == 0) misc[0] = (int)atomicAdd(ctr, 1u);
        __syncthreads();
        const int item = misc[0];
        if (item >= AT_ITEMS) break;
        prev_pm = cur_pm;
        const bool smp = item < 128;
        int b, h, x, kt_hi, qrow0, tpos0; size_t krow0;
        if (!smp) { const int it = item - 128; x = it >> 6; const int bh = it & 63; b = bh >> 4; h = bh & 15; kt_hi = 4 * x + 3; qrow0 = b * 2048 + x * 256 + 32 * wid; tpos0 = x * 256 + 32 * wid; krow0 = (size_t)b * 2048; cur_pm = b * 8 + x; }
        else { x = 0; const int bh = item; b = bh >> 4; h = bh & 15; kt_hi = 16; qrow0 = MP + b * 32; tpos0 = 1024; krow0 = 0; cur_pm = 32; }
        const bool active = !smp || wid == 0;
        AT_ENSURE(cur_pm);
        bf16x8 qf[2][4];
#pragma unroll
        for (int mt = 0; mt < 2; ++mt)
#pragma unroll
            for (int kk = 0; kk < 4; ++kk) qf[mt][kk] = *(const bf16x8*)(qb + (size_t)(qrow0 + 16 * mt + fr) * DM + h * 128 + 32 * kk + 8 * fq);
        f32x4 o[2][8];
#pragma unroll
        for (int mt = 0; mt < 2; ++mt)
#pragma unroll
            for (int dt = 0; dt < 8; ++dt) o[mt][dt] = (f32x4){0.f, 0.f, 0.f, 0.f};
        float C[2] = {0.f, 0.f};
        bool wdone = !active;
        if (lane == 0) misc[8 + wid] = wdone ? 1 : 0;
        f32x4 pf[2][4];
        if (!smp) {
#pragma unroll
            for (int i = 0; i < 2; ++i) { const int cid = tid + 512 * i, key = cid >> 4, d8 = (cid & 15) * 8; const size_t off = (krow0 + kt_hi * 64 + key) * DM + h * 128 + d8;
                pf[i][0] = __builtin_bit_cast(f32x4, *(const u32x4*)(kb + off)); pf[i][2] = __builtin_bit_cast(f32x4, *(const u32x4*)(vb + off)); }
        }
        for (int kt = kt_hi; kt >= 0; --kt) {
            __syncthreads();
            {
                int alld = 1;
#pragma unroll
                for (int w = 0; w < 8; ++w) alld &= misc[8 + w];
                if (alld) break;
            }
#pragma unroll
            for (int i = 0; i < 2; ++i) {
                const int cid = tid + 512 * i, key = cid >> 4, d8 = (cid & 15) * 8;
                u32x4 kwv, vwv;
                if (!smp) { kwv = __builtin_bit_cast(u32x4, pf[i][0]); vwv = __builtin_bit_cast(u32x4, pf[i][2]); }
                else if (kt == 16) {
                    if (key < 32) { const size_t off = (size_t)(MP + b * 32 + key) * DM + h * 128 + d8; kwv = *(const u32x4*)(kb + off); vwv = *(const u32x4*)(vb + off); }
                    else { kwv = (u32x4){0u, 0u, 0u, 0u}; vwv = kwv; }
                } else {
                    const f32x4 k0 = pf[i][0], k1 = pf[i][1], v0 = pf[i][2], v1 = pf[i][3];
                    kwv.x = cvt_pk_bf16(k0[0], k0[1]); kwv.y = cvt_pk_bf16(k0[2], k0[3]); kwv.z = cvt_pk_bf16(k1[0], k1[1]); kwv.w = cvt_pk_bf16(k1[2], k1[3]);
                    vwv.x = cvt_pk_bf16(v0[0], v0[1]); vwv.y = cvt_pk_bf16(v0[2], v0[3]); vwv.z = cvt_pk_bf16(v1[0], v1[1]); vwv.w = cvt_pk_bf16(v1[2], v1[3]);
                }
                *(LAS u32x4*)(Kl + key * AT_P + d8) = kwv; *(LAS u32x4*)(Vl + key * AT_P + d8) = vwv;
            }
            if (kt > 0 && !smp) AT_ENSURE(b * 8 + ((kt - 1) >> 2));
            if (kt > 0) {
#pragma unroll
                for (int i = 0; i < 2; ++i) {
                    const int cid = tid + 512 * i, key = cid >> 4, d8 = (cid & 15) * 8;
                    if (!smp) { const size_t off = (krow0 + (kt - 1) * 64 + key) * DM + h * 128 + d8; pf[i][0] = __builtin_bit_cast(f32x4, *(const u32x4*)(kb + off)); pf[i][2] = __builtin_bit_cast(f32x4, *(const u32x4*)(vb + off)); }
                    else { const size_t off = (((size_t)b * 1024 + (kt - 1) * 64 + key) * 16 + h) * 128 + d8;
                        pf[i][0] = *(const f32x4*)(p.ck + off); pf[i][1] = *(const f32x4*)(p.ck + off + 4); pf[i][2] = *(const f32x4*)(p.cv + off); pf[i][3] = *(const f32x4*)(p.cv + off + 4); }
                }
            }
            __syncthreads();
            if (!wdone && kt * 64 < tpos0 + 31) {
                f32x4 st[2][4];
#pragma unroll
                for (int mt = 0; mt < 2; ++mt)
#pragma unroll
                    for (int n = 0; n < 4; ++n) st[mt][n] = (f32x4){0.f, 0.f, 0.f, 0.f};
#pragma unroll
                for (int kk = 0; kk < 4; ++kk)
#pragma unroll
                    for (int n = 0; n < 4; ++n) {
                        const bf16x8 kf = *(const LAS bf16x8*)(Kl + (16 * (fr >> 2) + 4 * n + (fr & 3)) * AT_P + 32 * kk + 8 * fq);
                        st[0][n] = __builtin_amdgcn_mfma_f32_16x16x32_bf16(kf, qf[0][kk], st[0][n], 0, 0, 0);
                        st[1][n] = __builtin_amdgcn_mfma_f32_16x16x32_bf16(kf, qf[1][kk], st[1][n], 0, 0, 0);
                    }
                bf16x8 pb[2][2];
                {
                    const int s0 = kt * 64 + 16 * fq, tq0 = tpos0 + fr, tq1 = tpos0 + 16 + fr;
                    f32x2 run = (f32x2){0.f, 0.f};
#pragma unroll
                    for (int idx = 15; idx >= 0; --idx) {
                        const f32x2 xv = (f32x2){st[0][idx >> 2][idx & 3], st[1][idx >> 2][idx & 3]};
                        const f32x2 ax = __builtin_elementwise_abs(xv);
                        f32x2 e; e.x = __builtin_amdgcn_exp2f(-ax.x); e.y = __builtin_amdgcn_exp2f(-ax.y);
                        const f32x2 e1 = e + 1.0f;
                        f32x2 lg; lg.x = __builtin_amdgcn_logf(e1.x); lg.y = __builtin_amdgcn_logf(e1.y);
                        const f32x2 sp = __builtin_elementwise_max(xv, (f32x2){0.f, 0.f}) + lg;
                        const f32x2 lw = (xv - sp) + run;
                        st[0][idx >> 2][idx & 3] = lw.x; st[1][idx >> 2][idx & 3] = lw.y;
                        f32x2 dec; dec.x = (s0 + idx) < tq0 ? sp.x : 0.f; dec.y = (s0 + idx) < tq1 ? sp.y : 0.f;
                        run = run - dec;
                    }
                    f32x2 t16, t32, t48;
                    t16.x = __shfl(run.x, (lane + 16) & 63); t16.y = __shfl(run.y, (lane + 16) & 63);
                    t32.x = __shfl(run.x, (lane + 32) & 63); t32.y = __shfl(run.y, (lane + 32) & 63);
                    t48.x = __shfl(run.x, (lane + 48) & 63); t48.y = __shfl(run.y, (lane + 48) & 63);
                    const f32x2 z2 = (f32x2){0.f, 0.f};
                    const f32x2 higher = (fq < 3 ? t16 : z2) + (fq < 2 ? t32 : z2) + (fq < 1 ? t48 : z2);
                    const f32x2 base = (f32x2){C[0], C[1]} + higher;
                    const f32x2 tot = (run + t16) + (t32 + t48);
                    C[0] += tot.x; C[1] += tot.y;
                    float w0[16], w1[16];
#pragma unroll
                    for (int idx = 0; idx < 16; ++idx) {
                        const f32x2 a2 = (f32x2){st[0][idx >> 2][idx & 3], st[1][idx >> 2][idx & 3]} + base;
                        w0[idx] = (s0 + idx) < tq0 ? __builtin_amdgcn_exp2f(a2.x) : 0.f;
                        w1[idx] = (s0 + idx) < tq1 ? __builtin_amdgcn_exp2f(a2.y) : 0.f;
                    }
#pragma unroll
                    for (int k2 = 0; k2 < 2; ++k2) {
                        u32x4 pw; pw.x = cvt_pk_bf16(w0[8 * k2 + 0], w0[8 * k2 + 1]); pw.y = cvt_pk_bf16(w0[8 * k2 + 2], w0[8 * k2 + 3]); pw.z = cvt_pk_bf16(w0[8 * k2 + 4], w0[8 * k2 + 5]); pw.w = cvt_pk_bf16(w0[8 * k2 + 6], w0[8 * k2 + 7]);
                        pb[0][k2] = __builtin_bit_cast(bf16x8, pw);
                        u32x4 pv; pv.x = cvt_pk_bf16(w1[8 * k2 + 0], w1[8 * k2 + 1]); pv.y = cvt_pk_bf16(w1[8 * k2 + 2], w1[8 * k2 + 3]); pv.z = cvt_pk_bf16(w1[8 * k2 + 4], w1[8 * k2 + 5]); pv.w = cvt_pk_bf16(w1[8 * k2 + 6], w1[8 * k2 + 7]);
                        pb[1][k2] = __builtin_bit_cast(bf16x8, pv);
                    }
                }
#pragma unroll
                for (int k2 = 0; k2 < 2; ++k2)
#pragma unroll
                    for (int dt = 0; dt < 8; ++dt) {
                        const LAS bf16_t* a0 = Vl + (16 * fq + 8 * k2 + (fr >> 2)) * AT_P + 16 * dt + 4 * (fr & 3);
                        const s16x4 lo = __builtin_amdgcn_ds_read_tr16_b64_v4i16((LAS s16x4*)a0), hi = __builtin_amdgcn_ds_read_tr16_b64_v4i16((LAS s16x4*)(a0 + 4 * AT_P));
                        const bf16x8 vf = (bf16x8){lo[0], lo[1], lo[2], lo[3], hi[0], hi[1], hi[2], hi[3]};
                        o[0][dt] = __builtin_amdgcn_mfma_f32_16x16x32_bf16(vf, pb[0][k2], o[0][dt], 0, 0, 0);
                        o[1][dt] = __builtin_amdgcn_mfma_f32_16x16x32_bf16(vf, pb[1][k2], o[1][dt], 0, 0, 0);
                    }
                if (__builtin_amdgcn_ballot_w64(C[0] < -160.f && C[1] < -160.f) == ~0ull) { wdone = true;     if (lane == 0) misc[8 + wid] = 1; }
            }
        }
        asm volatile("s_waitcnt vmcnt(0)" ::: "memory");
        __syncthreads();
        if (tid == 0 && prev_pm >= 0) __hip_atomic_fetch_add(pcnt + 64 * prev_pm, 1u, __ATOMIC_RELAXED, __HIP_MEMORY_SCOPE_AGENT);
        if (active) {
#pragma unroll
            for (int mt = 0; mt < 2; ++mt)
#pragma unroll
                for (int dt = 0; dt < 8; ++dt) {
                    const size_t off = (size_t)(qrow0 + 16 * mt + fr) * DM + h * 128 + 16 * dt + 4 * fq;
                    const u32x2 zr = *(const u32x2*)(sz1 + off); const f32x4 a = o[mt][dt];
                    u32x2 w; w.x = cvt_pk_bf16(a[0] * bf_lo(zr.x), a[1] * bf_hi(zr.x)); w.y = cvt_pk_bf16(a[2] * bf_lo(zr.y), a[3] * bf_hi(zr.y));
                    st_wt8(y1 + off, w);
                }
        }
        if (smp) {
            asm volatile("s_waitcnt vmcnt(0)" ::: "memory");
            __syncthreads();
            if (tid == 0) __hip_atomic_fetch_add(pcnt + 64 * 32, 1u, __ATOMIC_RELAXED, __HIP_MEMORY_SCOPE_AGENT);
            cur_pm = -1;
        }
    }
    asm volatile("s_waitcnt vmcnt(0)" ::: "memory");
    __syncthreads();
    if (tid == 0 && cur_pm >= 0) __hip_atomic_fetch_add(pcnt + 64 * cur_pm, 1u, __ATOMIC_RELAXED, __HIP_MEMORY_SCOPE_AGENT);
}

#undef AT_ENSURE
__device__ __forceinline__ void final_phase(const Params& p, int G) {
    int tid_ = threadIdx.x; asm volatile("" : "+v"(tid_)); const int tid = tid_, lane = tid & 63, wave = tid >> 6;
    const float* ss2 = (const float*)(p.ws + WS_SS2);
    for (int m = blockIdx.x * 8 + wave; m < MT; m += G * 8) {
        const float s = wave_sum(lane < 32 ? ss2[(size_t)m * 32 + lane] : 0.f);
        const float rinv = __builtin_amdgcn_rsqf(s * (1.0f / DM) + 1e-6f);
        float* row = p.out + (size_t)m * DM;
#pragma unroll
        for (int j = 0; j < 8; ++j) { const f32x4 v = *(const f32x4*)(row + 4 * lane + 256 * j), gg = *(const f32x4*)(p.fng + 4 * lane + 256 * j); *(f32x4*)(row + 4 * lane + 256 * j) = v * rinv * gg; }
    }
}


#define XB_TMO      128
#define XB_XCNT(j)  (256  + 64 * (j))
#define XB_XSUB(j)  (1280 + 64 * (j))
#define XB_XGEN(j)  (2304 + 64 * (j))
#define XB_TOP      3328
#define XB_TOPGEN   3392
#define XCD_BAR_WORDS 3456
#define XB_SPIN_CAP (1u << 20)
__device__ __forceinline__ unsigned xb_ld(unsigned* p)              { return __hip_atomic_load(p, __ATOMIC_RELAXED, __HIP_MEMORY_SCOPE_AGENT); }
__device__ __forceinline__ unsigned xb_add(unsigned* p, unsigned v) { return __hip_atomic_fetch_add(p, v, __ATOMIC_RELAXED, __HIP_MEMORY_SCOPE_AGENT); }
__device__ __forceinline__ unsigned xb_xcc_id() { return (unsigned)__builtin_amdgcn_s_getreg((3 << 11) | 20) & 0xFu; }
#define XB_SPIN(cond, bar) do { unsigned _sp = 0; while (cond) { __builtin_amdgcn_s_sleep(1); \
    if ((++_sp & 255u) == 0u) { if (xb_ld(&(bar)[XB_TMO])) break; if (_sp > XB_SPIN_CAP) { atomicAdd(&(bar)[XB_TMO], 1u); break; } } } } while (0)
struct XcdBarrier { unsigned* bar; unsigned x; volatile LAS unsigned* st; };
__device__ __forceinline__ XcdBarrier xcd_barrier_post(unsigned* bar, volatile LAS unsigned* st) {
    XcdBarrier b; b.bar = bar; b.x = xb_xcc_id(); b.st = st;
    if (threadIdx.x == 0) (void)xb_add(&bar[XB_XCNT(b.x)], 1u);
    return b;
}
__device__ __forceinline__ void xcd_barrier_complete(unsigned* bar, unsigned x, unsigned& nloc, unsigned& nx) {
    const unsigned G = gridDim.x * gridDim.y * gridDim.z;
    unsigned sum, cnt, mine, sp = 0u;
    for (;;) {
        sum = 0u; cnt = 0u; mine = 0u;
#pragma unroll
        for (unsigned j = 0; j < 16; ++j) { const unsigned c = xb_ld(&bar[XB_XCNT(j)]); sum += c; cnt += (c > 0u) ? 1u : 0u; mine = (j == x) ? c : mine; }
        if (sum == G) break;
        __builtin_amdgcn_s_sleep(1);
        if ((++sp & 255u) == 0u) { if (xb_ld(&bar[XB_TMO])) break; if (sp > XB_SPIN_CAP) { atomicAdd(&bar[XB_TMO], 1u); break; } }
    }
    nloc = mine > 0u ? mine : 1u; nx = cnt > 0u ? cnt : 1u;
}
__device__ __forceinline__ void xcd_barrier(const XcdBarrier& b) {
    asm volatile("s_waitcnt vmcnt(0)" ::: "memory");
    __syncthreads();
    if (threadIdx.x == 0) {
        unsigned* bar = b.bar;
        __builtin_amdgcn_s_waitcnt(0);
        unsigned nloc = b.st[0], nx = b.st[1];
        if (nloc == 0u) { xcd_barrier_complete(bar, b.x, nloc, nx); b.st[0] = nloc; b.st[1] = nx; }
        const unsigned old = xb_add(&bar[XB_XSUB(b.x)], 1u);
        const unsigned gen = old / nloc;
        if (old + 1u == (gen + 1u) * nloc) {
            __builtin_amdgcn_fence(__ATOMIC_RELEASE, "agent");
            asm volatile("s_waitcnt vmcnt(0)" ::: "memory");
            const unsigned og = xb_add(&bar[XB_TOP], 1u);
            const unsigned tg = og / nx;
            if (og + 1u == (tg + 1u) * nx) xb_add(&bar[XB_TOPGEN], 1u);
            else XB_SPIN(xb_ld(&bar[XB_TOPGEN]) == tg, bar);
            __builtin_amdgcn_fence(__ATOMIC_ACQUIRE, "agent");
            xb_add(&bar[XB_XGEN(b.x)], 1u);
            asm volatile("s_waitcnt vmcnt(0)" ::: "memory");
        } else {
            XB_SPIN(xb_ld(&bar[XB_XGEN(b.x)]) == gen, bar);
            __builtin_amdgcn_fence(__ATOMIC_ACQUIRE, "agent");
            asm volatile("s_waitcnt vmcnt(0)" ::: "memory");
        }
    }
    __syncthreads();
}

#ifndef DUP
#define DUP 0
#endif
constexpr int LDS_BYTES = 131072 + 4096 + 8192;
__global__ void __launch_bounds__(512, 2) fwd_megakernel(Params p) {
    extern __shared__ __attribute__((aligned(16))) unsigned char lds_raw[];
    LAS unsigned char* lds = (LAS unsigned char*)lds_raw;
    cg::grid_group grid = cg::this_grid();
    const int G = gridDim.x;
    bf16_t* RA = (bf16_t*)(p.ws + WS_RA); bf16_t* RB = (bf16_t*)(p.ws + WS_RB);
    volatile LAS unsigned* xst = (volatile LAS unsigned*)(lds + 131072 + 2048);
    if (threadIdx.x < 4) xst[threadIdx.x] = 0u;
    __syncthreads();
    const XcdBarrier xbar = xcd_barrier_post((unsigned*)(p.ws + WS_CTL) + 1024, xst);
    p0_prologue(p, lds, G);
    if (DUP == 1) { __syncthreads(); p0_prologue(p, lds, G); }
    if (p.ws == nullptr) grid.sync();
    xcd_barrier(xbar);
    {
        pg8::Gemm g{RA, (const bf16_t*)(p.ws + WS_W1T), MT, N1, DM}; pg8::OrderG1 S; S.init(G, (int)blockIdx.x, (unsigned*)(p.ws + WS_CTL) + 11264);
        EpiG1 E{RB, (f32x2*)(p.ws + WS_LNP), (LAS f32x2*)(lds + 131072 + 4096)};
        pg8::gemm_phase<EpiG1, pg8::OrderG1>(lds, g, S, E);
    }
    mix_phase(p, lds, G, false);
    xcd_barrier(xbar);
    {
        unsigned* cnt = (unsigned*)(p.ws + WS_CTL) + 5120;
        {
            pg8::Gemm g{RB, (const bf16_t*)(p.ws + WS_W2T), MT, DM, GW}; pg8::OrderG2 S; S.init(G, (int)blockIdx.x, cnt);
            EpiRes<true> E{p.xp, p.xs, p.out, RA, (float*)(p.ws + WS_SS1)};
            pg8::gemm_phase<EpiRes<true>, pg8::OrderG2>(lds, g, S, E);
        }
        {
            pg8::Gemm g{RA, (const bf16_t*)(p.ws + WS_W3T), MT, N3, DM}; pg8::OrderG3 S; S.init(G, (int)blockIdx.x, cnt, (unsigned*)(p.ws + WS_CTL) + 20480);
            EpiG3 E{RB + 2 * SZ_D, (const float*)(p.ws + WS_SS1), p.out};
            pg8::gemm_phase<EpiG3, pg8::OrderG3>(lds, g, S, E);
        }
    }
    if (!(G == 256 && blockIdx.x < 8)) attn_phase(p, lds, 0);
    if (G == 256) {
        pg8::Gemm g{(const bf16_t*)(p.ws + WS_W1T), (const bf16_t*)(p.ws + WS_W4T), MT, DM, DM}; pg8::OrderG4 S; S.init(G, (int)blockIdx.x, (unsigned*)(p.ws + WS_CTL) + 8192);
        EpiFinal E{p.out, (float*)(p.ws + WS_SS2), p.fng, (unsigned*)(p.ws + WS_CTL) + 14336};
        pg8::gemm_phase<EpiFinal, pg8::OrderG4>(lds, g, S, E);
        return;
    }
    {
        pg8::Gemm g{(const bf16_t*)(p.ws + WS_W1T), (const bf16_t*)(p.ws + WS_W4T), MT, DM, DM}; pg8::OrderG4 S; S.init(G, (int)blockIdx.x, (unsigned*)(p.ws + WS_CTL) + 8192);
        EpiRes<false> E{nullptr, nullptr, p.out, nullptr, (float*)(p.ws + WS_SS2)};
        pg8::gemm_phase<EpiRes<false>, pg8::OrderG4>(lds, g, S, E);
    }
    xcd_barrier(xbar);
    final_phase(p, G);
}

extern "C" void kernel_launch(void* const* d_in, const int* in_sizes, int n_in, void* d_out, int out_size, void* d_ws, size_t ws_size, hipStream_t stream) {
    static int grid_blocks = 0;
    if (!grid_blocks) {
        int dev = 0, cus = 0, per_cu = 0;
        (void)hipGetDevice(&dev);
        (void)hipDeviceGetAttribute(&cus, hipDeviceAttributeMultiprocessorCount, dev);
        (void)hipFuncSetAttribute((const void*)fwd_megakernel, hipFuncAttributeMaxDynamicSharedMemorySize, LDS_BYTES);
        (void)hipOccupancyMaxActiveBlocksPerMultiprocessor(&per_cu, (const void*)fwd_megakernel, 512, LDS_BYTES);
        if (per_cu < 1) per_cu = 1;
        grid_blocks = cus * per_cu;
        if (ws_size < 348 * MiB) fprintf(stderr, "kernel_launch: workspace too small: %zu\n", ws_size);
    }
    (void)hipMemsetAsync((char*)d_ws + WS_CTL, 0, 131072, stream);
    Params p{};
    p.xp = (const float*)d_in[0]; p.xs = (const float*)d_in[1]; p.ck = (const float*)d_in[2]; p.cv = (const float*)d_in[3]; p.norm_g = (const float*)d_in[4]; p.fng = (const float*)d_in[5];
    p.w1 = (const float*)d_in[6]; p.lng = (const float*)d_in[7]; p.lnb = (const float*)d_in[8]; p.wsp = (const float*)d_in[9]; p.bsp = (const float*)d_in[10]; p.w2 = (const float*)d_in[11];
    p.w3 = (const float*)d_in[12]; p.w4 = (const float*)d_in[13]; p.out = (float*)d_out; p.ws = (unsigned char*)d_ws;
    void* args[] = {&p};
    hipError_t e = hipLaunchCooperativeKernel((void*)fwd_megakernel, dim3(grid_blocks), dim3(512), args, LDS_BYTES, stream);
    if (e != hipSuccess) fprintf(stderr, "cooperative launch failed: %s (grid %d)\n", hipGetErrorString(e), grid_blocks);
}
```

```cpp
#include <hip/hip_runtime.h>
#include <hip/hip_cooperative_groups.h>
#include <cstdio>
#include <cstdint>
namespace cg = cooperative_groups;

#define LAS __attribute__((address_space(3)))
typedef unsigned short bf16_t;
typedef short bf16x8 __attribute__((ext_vector_type(8)));
typedef short s16x4 __attribute__((ext_vector_type(4)));
typedef float f32x4 __attribute__((ext_vector_type(4)));
typedef float f32x2 __attribute__((ext_vector_type(2)));
typedef unsigned u32x4 __attribute__((ext_vector_type(4)));
typedef unsigned u32x2 __attribute__((ext_vector_type(2)));

constexpr int DM = 2048, MP = 8192, MS = 256, MT = MP + MS;
constexpr int GW = 4096, N1 = 3 * GW, N3 = 4 * DM;
constexpr size_t MiB = 1u << 20;
constexpr size_t WS_CTL = 0;
constexpr size_t WS_W1T = 4 * MiB, WS_W2T = 52 * MiB, WS_W3T = 68 * MiB, WS_W4T = 100 * MiB;
constexpr size_t WS_RA = 108 * MiB;
constexpr size_t WS_RB = 141 * MiB;
constexpr size_t WS_LNP = 339 * MiB;
constexpr size_t WS_SS1 = 344 * MiB;
constexpr size_t WS_SS2 = 346 * MiB;
constexpr size_t SZ_G = (size_t)MT * GW;
constexpr size_t SZ_D = (size_t)MT * DM;
constexpr size_t O_YP = 0, O_YS = (size_t)MP * DM, O_KP = O_YS + (size_t)MS * DM, O_VP = O_KP + (size_t)MP * DM, O_KS = O_VP + (size_t)MP * DM, O_VS = O_KS + (size_t)MS * DM, O_GMV = O_VS + (size_t)MS * DM;

struct Params {
    const float* xp; const float* xs; const float* ck; const float* cv; const float* norm_g; const float* fng;
    const float* w1; const float* lng; const float* lnb; const float* wsp; const float* bsp; const float* w2; const float* w3; const float* w4;
    float* out; unsigned char* ws;
};

__device__ __forceinline__ unsigned cvt_pk_bf16(float lo, float hi) { unsigned r; asm volatile("v_cvt_pk_bf16_f32 %0, %1, %2" : "=v"(r) : "v"(lo), "v"(hi)); return r; }
__device__ __forceinline__ void st_wt16(void* ptr, u32x4 v) { asm volatile("global_store_dwordx4 %0, %1, off sc1\n\ts_nop 1" :: "v"(ptr), "v"(v) : "memory"); }
__device__ __forceinline__ void st_wt8(void* ptr, u32x2 v) { asm volatile("global_store_dwordx2 %0, %1, off sc1" :: "v"(ptr), "v"(v) : "memory"); }
__device__ __forceinline__ void st_wt4(void* ptr, unsigned v) { asm volatile("global_store_dword %0, %1, off sc1" :: "v"(ptr), "v"(v) : "memory"); }
__device__ __forceinline__ float bf_lo(unsigned w) { return __uint_as_float(w << 16); }
__device__ __forceinline__ float bf_hi(unsigned w) { return __uint_as_float(w & 0xffff0000u); }
__device__ __forceinline__ float fast_sigmoid_mul(float x, float arg) { return x * __builtin_amdgcn_rcpf(1.0f + __builtin_amdgcn_exp2f(-1.4426950408889634f * arg)); }
__device__ __forceinline__ float gelu_tanh(float x) { return fast_sigmoid_mul(x, x * (1.5957691216057308f + 0.07135481627260025f * x * x)); }
__device__ __forceinline__ float silu(float x) { return fast_sigmoid_mul(x, x); }
__device__ __forceinline__ f32x2 exp2_2(f32x2 a) { f32x2 r; r.x = __builtin_amdgcn_exp2f(a.x); r.y = __builtin_amdgcn_exp2f(a.y); return r; }
__device__ __forceinline__ f32x2 rcp_2(f32x2 a) { f32x2 r; r.x = __builtin_amdgcn_rcpf(a.x); r.y = __builtin_amdgcn_rcpf(a.y); return r; }
__device__ __forceinline__ f32x2 gelu_den2(f32x2 x) { return exp2_2(x * ((x * x) * (-0.10294324f) + (-2.3022082f))) + 1.0f; }
__device__ __forceinline__ f32x2 silu_den2(f32x2 x) { return exp2_2(x * (-1.4426950408889634f)) + 1.0f; }
__device__ __forceinline__ f32x2 gelu2(f32x2 x) { return x * rcp_2(gelu_den2(x)); }
__device__ __forceinline__ f32x2 silu2(f32x2 x) { return x * rcp_2(silu_den2(x)); }
__device__ __forceinline__ f32x2 guz2(f32x2 u, f32x2 z) { return (u * z) * rcp_2(gelu_den2(u) * silu_den2(z)); }
__device__ __forceinline__ float wave_sum(float v) {
#pragma unroll
    for (int o = 1; o < 64; o <<= 1) v += __shfl_xor(v, o);
    return v;
}

namespace pg8 {
constexpr int BM = 256, BK = 64, HALF = 128, HTB = HALF * BK * 2, STAGE_BYTES = 8 * HTB, NXCD = 8, WGM = 8;
__host__ __device__ __forceinline__ int lds_byte(int r, int c) { const int st = (r >> 4) * 2 + (c >> 5), rr = r & 15, cc = c & 31, ob = rr * 64 + cc * 2; return st * 1024 + (ob ^ (((ob >> 9) & 1) << 5)); }
__host__ __device__ __forceinline__ void stage_rc(int b, int& R, int& C) { const int st = b / 1024, sb = b % 1024, swz = sb ^ (((sb >> 9) & 1) << 5); R = (st >> 1) * 16 + swz / 64; C = (st & 1) * 32 + (swz % 64) / 2; }
__host__ __device__ __forceinline__ int perm32(int rho) { const int n = rho >> 4, i = rho & 15; return 8 * (i >> 2) + 4 * n + (i & 3); }
struct Unit { int pm, pn; };
struct Gemm { const bf16_t* A; const bf16_t* Bt; int M, N, K; };
struct StaticOrder {
    static constexpr bool PUBLISH = false; unsigned* cnt = nullptr; unsigned* pub = nullptr;
    int nM, nN, nwg, G, c;
    __host__ __device__ void init(int M, int N, int G_, int c_) { nM = M / BM; nN = N / BM; nwg = nM * nN; G = G_; c = c_; }
    __host__ __device__ bool next(int i, Unit& u) const {
        const long L = (long)i * G + c; if (L >= nwg) return false;
        int wgid = (int)L; { const int q = nwg / NXCD, r = nwg % NXCD, xcd = wgid % NXCD, off = wgid / NXCD; wgid = (xcd < r ? xcd * (q + 1) : r * (q + 1) + (xcd - r) * q) + off; }
        const int nig = WGM * nN, gid = wgid / nig, fm = gid * WGM, gsz = (nM - fm) < WGM ? (nM - fm) : WGM;
        u.pm = fm + ((wgid % nig) % gsz); u.pn = (wgid % nig) / gsz; return true;
    }
    __device__ __forceinline__ void a_ready(const Unit&) const {}
    __device__ __forceinline__ void done(const Unit&) const {}
};
__device__ __forceinline__ void panel_publish(unsigned* cnt, int pm) {
    asm volatile("s_waitcnt vmcnt(0)" ::: "memory");
    __builtin_amdgcn_s_barrier();
    if (threadIdx.x < 64) {
        __builtin_amdgcn_fence(__ATOMIC_RELEASE, "agent");
        asm volatile("s_waitcnt vmcnt(0)" ::: "memory");
        if (threadIdx.x == 0) __hip_atomic_fetch_add(cnt + 64 * pm, 1u, __ATOMIC_RELAXED, __HIP_MEMORY_SCOPE_AGENT);
    }
}
__device__ __forceinline__ void panel_publish_wt(unsigned* cnt, int pm) {
    asm volatile("s_waitcnt vmcnt(0)" ::: "memory");
    __builtin_amdgcn_s_barrier();
    if (threadIdx.x == 0) __hip_atomic_fetch_add(cnt + 64 * pm, 1u, __ATOMIC_RELAXED, __HIP_MEMORY_SCOPE_AGENT);
}
__device__ __forceinline__ void panel_wait_wave0(unsigned* cnt, int pm, unsigned need) {
    unsigned polls = 0;
    while ((unsigned)__builtin_amdgcn_readfirstlane(__hip_atomic_load(cnt + 64 * pm, __ATOMIC_RELAXED, __HIP_MEMORY_SCOPE_AGENT)) < need) {
        __builtin_amdgcn_s_sleep(2);
        if (++polls > (1u << 22)) break;
    }
    __builtin_amdgcn_fence(__ATOMIC_ACQUIRE, "agent");
    asm volatile("s_waitcnt vmcnt(0)" ::: "memory");
}
struct OrderG1 {
    static constexpr bool PUBLISH = true;
    StaticOrder P; unsigned* cnt; unsigned* pub; int G, c;
    __device__ void init(int G_, int c_, unsigned* cnt_) { P.init(8192, 12288, G_, c_); G = G_; c = c_; cnt = cnt_; pub = cnt_; }
    __device__ bool next(int i, Unit& u) const { const int L = i * G + c; if (L < 1536) return P.next(i, u); if (L < 1584) { u.pm = 32; u.pn = L - 1536; return true; } return false; }
    __device__ __forceinline__ void a_ready(const Unit&) const {}
    __device__ __forceinline__ void done(const Unit& u) const { panel_publish_wt(cnt, u.pm); }
};
struct OrderG2 {
    static constexpr bool PUBLISH = true;
    StaticOrder P; unsigned* cnt; unsigned* pub; int G, c;
    __device__ void init(int G_, int c_, unsigned* cnt_) { P.init(8192, 2048, G_, c_); G = G_; c = c_; cnt = cnt_; pub = cnt_; }
    __device__ bool next(int i, Unit& u) const { const int L = i * G + c; if (L < 256) return P.next(i, u); if (L < 264) { u.pm = 32; u.pn = L - 256; return true; } return false; }
    __device__ __forceinline__ void a_ready(const Unit&) const {}
    __device__ __forceinline__ void done(const Unit& u) const { panel_publish_wt(cnt, u.pm); }
};
struct OrderG3 {
    static constexpr bool PUBLISH = true;
    StaticOrder P; unsigned* cnt; unsigned* pub; int G, c;
    __device__ void init(int G_, int c_, unsigned* cnt_, unsigned* pub_) { P.init(8192, 8192, G_, c_); G = G_; c = c_; cnt = cnt_; pub = pub_; }
    __device__ bool next(int i, Unit& u) const {
        if (G == 256) {
            if (i < 4) {
                if (c < 8 && i >= 2) return false;
                P.next(i, u);
                if ((u.pm & 7) == 7 && (u.pn < 4 || (u.pn >= 8 && u.pn < 16))) {
                    if (u.pn >= 8) { const int r = (u.pm >> 3) * 8 + (u.pn - 8); u.pm = 32; u.pn = r; }
                    else { const int j = (u.pm >> 3) * 4 + u.pn; StaticOrder Q = P; Q.c = j & 7; Q.next(2 + (j >> 3), u); }
                }
                return true;
            }
            if (i == 4 && c >= 8 && c < 56) { const int r = c - 8; if (r < 32) { u.pm = 8 * (r >> 3) + 7; u.pn = 8 + (r & 7); } else { const int j = r - 32; u.pm = 8 * (j >> 2) + 7; u.pn = j & 3; } return true; }
            return false;
        }
        const int L = i * G + c; if (L < 1024) return P.next(i, u); if (L < 1056) { u.pm = 32; u.pn = L - 1024; return true; } return false;
    }
    __device__ __forceinline__ void a_ready(const Unit& u) const {
        if (threadIdx.x < 64) panel_wait_wave0(cnt, u.pm, 8u);
        asm volatile("" ::: "memory"); __builtin_amdgcn_s_barrier(); asm volatile("" ::: "memory");
    }
    __device__ __forceinline__ void done(const Unit&) const {}
};
struct OrderG4 {
    static constexpr bool PUBLISH = false;
    StaticOrder P; unsigned* cnt; unsigned* pub = nullptr; int G, c;
    __device__ void init(int G_, int c_, unsigned* cnt_) { P.init(8192, 2048, G_, c_); G = G_; c = c_; cnt = cnt_; }
    __device__ bool next(int i, Unit& u) const {
        if (G == 256) { if (c < 8) { if (i == 0) { u.pm = 32; u.pn = c; return true; } return i == 1 ? P.next(0, u) : false; } return i == 0 ? P.next(0, u) : false; }
        const int L = i * G + c; if (L < 256) return P.next(i, u); if (L < 264) { u.pm = 32; u.pn = L - 256; return true; } return false;
    }
    __device__ __forceinline__ void a_ready(const Unit& u) const {
        if (threadIdx.x < 64) panel_wait_wave0(cnt, u.pm, u.pm == 32 ? 128u : 16u);
        asm volatile("" ::: "memory"); __builtin_amdgcn_s_barrier(); asm volatile("" ::: "memory");
    }
    __device__ __forceinline__ void done(const Unit&) const {}
};

template <class Epi, class Sched, bool ALIGN_EPI = true>
__device__ __forceinline__ void gemm_phase(LAS unsigned char* lds, const Gemm g, const Sched& S, const Epi& E) {
    int tid_ = threadIdx.x; asm volatile("" : "+v"(tid_)); const int tid = tid_, wid = __builtin_amdgcn_readfirstlane(tid >> 6), lane = tid & 63, wr = wid >> 2, wc = wid & 3, fr = lane & 15, fq = lane >> 4;
    const int K = g.K, nt = K / BK;
    unsigned voffA[2], voffB[2];
#pragma unroll
    for (int i = 0; i < 2; ++i) { int R, C; stage_rc(tid * 16 + i * 8192, R, C); const int Rb = Epi::PERM ? ((R & ~31) + perm32(R & 31)) : R;
        voffA[i] = (unsigned)(R * K + C) * 2u; voffB[i] = (unsigned)(Rb * K + C) * 2u; }
    const size_t kstep = (size_t)(BK * 2);
    const size_t hstep = (size_t)HALF * K * 2;
    const size_t tstep = 2 * hstep;
    const unsigned ldsw = (unsigned)wid * 1024u;
    const int aoff = lds_byte(wr * 64 + fr, fq * 8), boff = lds_byte(wc * 32 + fr, fq * 8);
#define PG8_SA(b, h) (((b) * 2 + (h)) * HTB)
#define PG8_SB(b, h) ((4 + (b) * 2 + (h)) * HTB)
#define PG8_STAGE(bufoff, gbase, voff) do { _Pragma("unroll") for (int _i = 0; _i < 2; ++_i) \
        __builtin_amdgcn_global_load_lds((const unsigned*)((const char*)(gbase) + (voff)[_i]), (LAS unsigned*)(lds + (bufoff) + ldsw + _i * 8192), 16, 0, 0); } while (0)
#define PG8_LDA(dst, b, h) do { _Pragma("unroll") for (int m = 0; m < 4; ++m) _Pragma("unroll") for (int k = 0; k < 2; ++k) dst[m][k] = *(const LAS bf16x8*)(lds + PG8_SA(b, h) + aoff + m * 2048 + k * 1024); } while (0)
#define PG8_LDB(dst, b, h) do { _Pragma("unroll") for (int n = 0; n < 2; ++n) _Pragma("unroll") for (int k = 0; k < 2; ++k) dst[n][k] = *(const LAS bf16x8*)(lds + PG8_SB(b, h) + boff + n * 2048 + k * 1024); } while (0)
#define PG8_MMA(ai, bj, At, Bt) do { __builtin_amdgcn_s_setprio(1); _Pragma("unroll") for (int m = 0; m < 4; ++m) _Pragma("unroll") for (int n = 0; n < 2; ++n) _Pragma("unroll") for (int k = 0; k < 2; ++k) \
        acc[ai][bj][m][n] = __builtin_amdgcn_mfma_f32_16x16x32_bf16(Bt[n][k], At[m][k], acc[ai][bj][m][n], 0, 0, 0); __builtin_amdgcn_s_setprio(0); } while (0)
#define PG8_WAIT_V(n) asm volatile("s_waitcnt vmcnt(" #n ")" ::: "memory")
#define PG8_WAIT_L(n) asm volatile("s_waitcnt lgkmcnt(" #n ")" ::: "memory")
#define PG8_BAR __builtin_amdgcn_s_barrier()
#define PG8_SCHED __builtin_amdgcn_sched_barrier(0)
    Unit cur, nxt; int ui = 0; int pend = -1;
    if (!S.next(0, cur)) return;
    f32x4 acc[2][2][4][2];
#pragma unroll
    for (int a = 0; a < 2; ++a)
#pragma unroll
        for (int b = 0; b < 2; ++b)
#pragma unroll
            for (int m = 0; m < 4; ++m)
#pragma unroll
                for (int n = 0; n < 2; ++n) acc[a][b][m][n] = (f32x4){0.f, 0.f, 0.f, 0.f};
    bf16x8 At[4][2], B0[2][2], B1[2][2];
    const char* cA = (const char*)g.A + (size_t)cur.pm * tstep; const char* cB = (const char*)g.Bt + (size_t)cur.pn * tstep;
    S.a_ready(cur);
    PG8_STAGE(PG8_SB(0, 0), cB, voffB); PG8_STAGE(PG8_SB(0, 1), cB + hstep, voffB); PG8_STAGE(PG8_SA(0, 0), cA, voffA); PG8_STAGE(PG8_SA(0, 1), cA + hstep, voffA);
    if (wr == 1) PG8_BAR;
    PG8_WAIT_V(2); PG8_BAR;
    PG8_STAGE(PG8_SB(1, 0), cB + kstep, voffB); PG8_STAGE(PG8_SA(1, 0), cA + kstep, voffA); PG8_STAGE(PG8_SB(1, 1), cB + hstep + kstep, voffB);
    PG8_WAIT_V(6); PG8_BAR;
    for (;;) {
        const bool has_next = S.next(ui + 1, nxt);
        const char* nA = has_next ? (const char*)g.A + (size_t)nxt.pm * tstep : cA; const char* nB = has_next ? (const char*)g.Bt + (size_t)nxt.pn * tstep : cB;
        for (int t = 0; t < nt; t += 2) {
            const bool last = (t == nt - 2);
            const char* a1 = cA + (size_t)(t + 1) * kstep;
            const char* a2 = last ? nA : cA + (size_t)(t + 2) * kstep; const char* b2 = last ? nB : cB + (size_t)(t + 2) * kstep;
            const char* a3 = a2 + kstep; const char* b3 = b2 + kstep;
            if (last && has_next) S.a_ready(nxt);
            if (Sched::PUBLISH && t == 4 && pend >= 0) {
                if (tid == 0) __hip_atomic_fetch_add(S.pub + 64 * pend, 1u, __ATOMIC_RELAXED, __HIP_MEMORY_SCOPE_AGENT);
                pend = -1;
            }
            PG8_LDB(B0, 0, 0); PG8_LDB(B1, 0, 1); PG8_SCHED; PG8_LDA(At, 0, 0); PG8_STAGE(PG8_SA(1, 1), a1 + hstep, voffA);
            PG8_WAIT_V(8); PG8_WAIT_L(0); PG8_BAR; PG8_MMA(0, 0, At, B0); PG8_MMA(0, 1, At, B1); PG8_BAR; PG8_SCHED;
            PG8_LDA(At, 0, 1); PG8_STAGE(PG8_SB(0, 0), b2, voffB); PG8_STAGE(PG8_SB(0, 1), b2 + hstep, voffB); PG8_STAGE(PG8_SA(0, 0), a2, voffA);
            PG8_WAIT_V(8); PG8_WAIT_L(0); PG8_BAR; PG8_MMA(1, 0, At, B0); PG8_MMA(1, 1, At, B1); PG8_BAR; PG8_SCHED;
            PG8_LDB(B0, 1, 0); PG8_LDB(B1, 1, 1); PG8_SCHED; PG8_LDA(At, 1, 0); PG8_STAGE(PG8_SA(0, 1), a2 + hstep, voffA);
            PG8_WAIT_V(8); PG8_WAIT_L(0); PG8_BAR; PG8_MMA(0, 0, At, B0); PG8_MMA(0, 1, At, B1); PG8_BAR; PG8_SCHED;
            PG8_LDA(At, 1, 1); PG8_STAGE(PG8_SB(1, 0), b3, voffB); PG8_STAGE(PG8_SB(1, 1), b3 + hstep, voffB); PG8_STAGE(PG8_SA(1, 0), a3, voffA);
            PG8_WAIT_V(8); PG8_WAIT_L(0); PG8_BAR; PG8_MMA(1, 0, At, B0); PG8_MMA(1, 1, At, B1); PG8_BAR; PG8_SCHED;
        }
        if constexpr (ALIGN_EPI) { if (wr == 0) PG8_BAR; }
        E(acc, cur, wr, wc, fr, fq); if (Sched::PUBLISH) pend = cur.pm;
        if (!has_next) break;
#pragma unroll
        for (int a = 0; a < 2; ++a)
#pragma unroll
            for (int b = 0; b < 2; ++b)
#pragma unroll
                for (int m = 0; m < 4; ++m)
#pragma unroll
                    for (int n = 0; n < 2; ++n) acc[a][b][m][n] = (f32x4){0.f, 0.f, 0.f, 0.f};
        cur = nxt; cA = nA; cB = nB; ++ui;
        if constexpr (ALIGN_EPI) { if (wr == 1) PG8_BAR; }
    }
    PG8_WAIT_V(0);
    if constexpr (!ALIGN_EPI) { if (wr == 0) PG8_BAR; }
    PG8_BAR;
    if (Sched::PUBLISH && pend >= 0 && tid == 0) __hip_atomic_fetch_add(S.pub + 64 * pend, 1u, __ATOMIC_RELAXED, __HIP_MEMORY_SCOPE_AGENT);
#undef PG8_SA
#undef PG8_SB
#undef PG8_STAGE
#undef PG8_LDA
#undef PG8_LDB
#undef PG8_MMA
#undef PG8_WAIT_V
#undef PG8_WAIT_L
#undef PG8_BAR
#undef PG8_SCHED
}
}

struct EpiG1 {
    static constexpr bool PERM = true;
    bf16_t* rb; f32x2* lnp; LAS f32x2* red;
    __device__ __forceinline__ void operator()(const f32x4 (&acc)[2][2][4][2], const pg8::Unit& u, int wr, int wc, int fr, int fq) const {
        const int row0 = u.pm * 256 + wr * 64 + fr;
        if (u.pn < 32) {
            const int col0 = u.pn * 128 + wc * 32 + 8 * fq;
#pragma unroll
            for (int ai = 0; ai < 2; ++ai)
#pragma unroll
                for (int m = 0; m < 4; ++m) {
                    const int row = row0 + ai * 128 + m * 16;
                    const f32x4 u0 = acc[ai][0][m][0], u1 = acc[ai][0][m][1], z0 = acc[ai][1][m][0], z1 = acc[ai][1][m][1];
                    const f32x2 a = guz2((f32x2){u0[0], u0[1]}, (f32x2){z0[0], z0[1]}), b = guz2((f32x2){u0[2], u0[3]}, (f32x2){z0[2], z0[3]});
                    const f32x2 c = guz2((f32x2){u1[0], u1[1]}, (f32x2){z1[0], z1[1]}), d = guz2((f32x2){u1[2], u1[3]}, (f32x2){z1[2], z1[3]});
                    u32x4 w; w.x = cvt_pk_bf16(a.x, a.y); w.y = cvt_pk_bf16(b.x, b.y); w.z = cvt_pk_bf16(c.x, c.y); w.w = cvt_pk_bf16(d.x, d.y);
                    st_wt16(rb + (size_t)row * GW + col0, w);
                }
        } else {
            const int pv = u.pn - 32;
            bf16_t* base = rb + SZ_G;
            const int col0 = pv * 256 + wc * 32 + 8 * fq;
#pragma unroll
            for (int ai = 0; ai < 2; ++ai)
#pragma unroll
                for (int m = 0; m < 4; ++m) {
                    const int row = row0 + ai * 128 + m * 16;
                    bf16_t* rowp = base + (size_t)row * GW + col0;
                    f32x2 s2 = (f32x2){0.f, 0.f}, q2 = s2;
#pragma unroll
                    for (int bj = 0; bj < 2; ++bj) {
                        const f32x4 x0 = acc[ai][bj][m][0], x1 = acc[ai][bj][m][1];
                        const f32x2 a = gelu2((f32x2){x0[0], x0[1]}), b = gelu2((f32x2){x0[2], x0[3]}), c = gelu2((f32x2){x1[0], x1[1]}), d = gelu2((f32x2){x1[2], x1[3]});
                        s2 += (a + b) + (c + d); q2 += (a * a + b * b) + (c * c + d * d);
                        u32x4 w; w.x = cvt_pk_bf16(a.x, a.y); w.y = cvt_pk_bf16(b.x, b.y); w.z = cvt_pk_bf16(c.x, c.y); w.w = cvt_pk_bf16(d.x, d.y);
                        st_wt16(rowp + bj * 128, w);
                    }
                    float s = s2.x + s2.y, q = q2.x + q2.y;
                    s += __shfl_xor(s, 16); s += __shfl_xor(s, 32); q += __shfl_xor(q, 16); q += __shfl_xor(q, 32);
                    if (fq == 0) red[(ai * 128 + wr * 64 + m * 16 + fr) * 4 + wc] = (f32x2){s, q};
                }
            asm volatile("s_waitcnt lgkmcnt(0)" ::: "memory"); __builtin_amdgcn_s_barrier(); asm volatile("" ::: "memory");
            if (threadIdx.x < 256) {
                const int r = threadIdx.x; const f32x2 a = red[r * 4 + 0], b = red[r * 4 + 1], c = red[r * 4 + 2], d = red[r * 4 + 3];
                st_wt8(lnp + (size_t)(u.pm * 256 + r) * 16 + pv, (u32x2){__float_as_uint((a[0] + b[0]) + (c[0] + d[0])), __float_as_uint((a[1] + b[1]) + (c[1] + d[1]))});
            }
        }
    }
};
template <bool FIRST> struct EpiRes {
    static constexpr bool PERM = false;
    const float* xp; const float* xs; float* oy; bf16_t* xb; float* ss;
    __device__ __forceinline__ void operator()(const f32x4 (&acc)[2][2][4][2], const pg8::Unit& u, int wr, int wc, int fr, int fq) const {
        const int row0 = u.pm * 256 + wr * 64 + fr, col0 = u.pn * 256 + wc * 32 + 4 * fq;
#pragma unroll
        for (int ai = 0; ai < 2; ++ai)
#pragma unroll
            for (int m = 0; m < 4; ++m) {
                const int row = row0 + ai * 128 + m * 16;
                float* orow = oy + (size_t)row * DM + col0;
                const float* xr = FIRST ? ((row < MP ? xp + (size_t)row * DM : xs + (size_t)(row - MP) * DM) + col0) : orow;
                float q = 0.f;
#pragma unroll
                for (int bj = 0; bj < 2; ++bj)
#pragma unroll
                    for (int n = 0; n < 2; ++n) {
                        const f32x4 xv = *(const f32x4*)(xr + bj * 128 + n * 16);
                        const f32x4 o = xv + acc[ai][bj][m][n];
                        *(f32x4*)(orow + bj * 128 + n * 16) = o;
                        q += (o[0] * o[0] + o[1] * o[1]) + (o[2] * o[2] + o[3] * o[3]);
                        if (FIRST) { u32x2 w; w.x = cvt_pk_bf16(o[0], o[1]); w.y = cvt_pk_bf16(o[2], o[3]); st_wt8(xb + (size_t)row * DM + col0 + bj * 128 + n * 16, w); }
                    }
                q += __shfl_xor(q, 16); q += __shfl_xor(q, 32);
                if (fq == 0) { if (FIRST) st_wt4(ss + (size_t)row * 32 + u.pn * 4 + wc, __float_as_uint(q)); else ss[(size_t)row * 32 + u.pn * 4 + wc] = q; }
            }
    }
};
struct EpiFinal {
    static constexpr bool PERM = false;
    float* oy; float* ss; const float* fng; unsigned* cnt;
    __device__ __forceinline__ void operator()(f32x4 (&acc)[2][2][4][2], const pg8::Unit& u, int wr, int wc, int fr, int fq) const {
        const int row0 = u.pm * 256 + wr * 64 + fr, col0 = u.pn * 256 + wc * 32 + 4 * fq;
#pragma unroll
        for (int ai = 0; ai < 2; ++ai)
#pragma unroll
            for (int m = 0; m < 4; ++m) {
                const int row = row0 + ai * 128 + m * 16;
                const float* xr = oy + (size_t)row * DM + col0;
                float q = 0.f;
#pragma unroll
                for (int bj = 0; bj < 2; ++bj)
#pragma unroll
                    for (int n = 0; n < 2; ++n) {
                        const f32x4 o = *(const f32x4*)(xr + bj * 128 + n * 16) + acc[ai][bj][m][n];
                        acc[ai][bj][m][n] = o;
                        q += (o[0] * o[0] + o[1] * o[1]) + (o[2] * o[2] + o[3] * o[3]);
                    }
                q += __shfl_xor(q, 16); q += __shfl_xor(q, 32);
                if (fq == 0) st_wt4(ss + (size_t)row * 32 + u.pn * 4 + wc, __float_as_uint(q));
            }
        asm volatile("s_waitcnt vmcnt(0)" ::: "memory");
        __builtin_amdgcn_s_barrier();
        if (threadIdx.x < 64) {
            if (threadIdx.x == 0) __hip_atomic_fetch_add(cnt + 64 * u.pm, 1u, __ATOMIC_RELAXED, __HIP_MEMORY_SCOPE_AGENT);
            pg8::panel_wait_wave0(cnt, u.pm, 8u);
        }
        asm volatile("" ::: "memory"); __builtin_amdgcn_s_barrier(); asm volatile("" ::: "memory");
        f32x4 gg[2][2];
#pragma unroll
        for (int bj = 0; bj < 2; ++bj)
#pragma unroll
            for (int n = 0; n < 2; ++n) gg[bj][n] = *(const f32x4*)(fng + col0 + bj * 128 + n * 16);
#pragma unroll
        for (int ai = 0; ai < 2; ++ai)
#pragma unroll
            for (int m = 0; m < 4; ++m) {
                const int row = row0 + ai * 128 + m * 16;
                const f32x4 pa = *(const f32x4*)(ss + (size_t)row * 32 + 8 * fq), pb = *(const f32x4*)(ss + (size_t)row * 32 + 8 * fq + 4);
                float sq = ((pa[0] + pa[1]) + (pa[2] + pa[3])) + ((pb[0] + pb[1]) + (pb[2] + pb[3]));
                sq += __shfl_xor(sq, 16); sq += __shfl_xor(sq, 32);
                const float rinv = __builtin_amdgcn_rsqf(sq * (1.0f / DM) + 1e-6f);
                float* orow = oy + (size_t)row * DM + col0;
#pragma unroll
                for (int bj = 0; bj < 2; ++bj)
#pragma unroll
                    for (int n = 0; n < 2; ++n) __builtin_nontemporal_store(acc[ai][bj][m][n] * rinv * gg[bj][n], (f32x4*)(orow + bj * 128 + n * 16));
            }
    }
};
struct EpiG3 {
    static constexpr bool PERM = true;
    bf16_t* rb; const float* ss1; float* out;
    __device__ __forceinline__ void operator()(const f32x4 (&acc)[2][2][4][2], const pg8::Unit& u, int wr, int wc, int fr, int fq) const {
        const int t = u.pn >> 3;
        bf16_t* base = rb + (size_t)t * SZ_D;
        const int row0 = u.pm * 256 + wr * 64 + fr, col0 = (u.pn & 7) * 256 + wc * 32 + 8 * fq;
#pragma unroll
        for (int ai = 0; ai < 2; ++ai)
#pragma unroll
            for (int m = 0; m < 4; ++m) {
                const int row = row0 + ai * 128 + m * 16;
                const f32x4 pa = *(const f32x4*)(ss1 + (size_t)row * 32 + 8 * fq), pb = *(const f32x4*)(ss1 + (size_t)row * 32 + 8 * fq + 4);
                float s = ((pa[0] + pa[1]) + (pa[2] + pa[3])) + ((pb[0] + pb[1]) + (pb[2] + pb[3]));
                s += __shfl_xor(s, 16); s += __shfl_xor(s, 32);
                float rinv = __builtin_amdgcn_rsqf(s * (1.0f / DM) + 1e-6f);
                if (t == 0) rinv *= 0.08838834764831845f * 1.4426950408889634f;
                bf16_t* rowp = base + (size_t)row * DM + col0;
                float* fo = nullptr;
                if (t == 1) fo = out + (row < MP ? O_KP + (size_t)row * DM : O_KS + (size_t)(row - MP) * DM) + col0;
                if (t == 2) fo = out + (row < MP ? O_VP + (size_t)row * DM : O_VS + (size_t)(row - MP) * DM) + col0;
#pragma unroll
                for (int bj = 0; bj < 2; ++bj) {
                    f32x4 v0 = acc[ai][bj][m][0] * rinv, v1 = acc[ai][bj][m][1] * rinv;
                    if (t == 3) {
                        const f32x2 a = silu2((f32x2){v0[0], v0[1]}), b = silu2((f32x2){v0[2], v0[3]}), c = silu2((f32x2){v1[0], v1[1]}), d = silu2((f32x2){v1[2], v1[3]});
                        v0 = (f32x4){a.x, a.y, b.x, b.y}; v1 = (f32x4){c.x, c.y, d.x, d.y};
                    }
                    if (t == 1 || t == 2) { __builtin_nontemporal_store(v0, (f32x4*)(fo + bj * 128)); __builtin_nontemporal_store(v1, (f32x4*)(fo + bj * 128 + 4)); }
                    u32x4 w; w.x = cvt_pk_bf16(v0[0], v0[1]); w.y = cvt_pk_bf16(v0[2], v0[3]); w.z = cvt_pk_bf16(v1[0], v1[1]); w.w = cvt_pk_bf16(v1[2], v1[3]);
                    st_wt16(rowp + bj * 128, w);
                }
            }
    }
};

__device__ __forceinline__ void p0_transpose_item(const float* W, int K, int N, bf16_t* WT, const float* gk, LAS float* scr, int item, int lane, bool w1map) {
    const int nblk = N / 32, kb = item / nblk, nb = item % nblk, k0 = 64 * kb, n0 = 32 * nb;
    int nd0 = n0;
    if (w1map) { if (n0 < GW) nd0 = (n0 >> 7) * 256 + (n0 & 127); else if (n0 < 2 * GW) nd0 = 2 * GW + (n0 - GW); else { const int c = n0 - 2 * GW; nd0 = (c >> 7) * 256 + 128 + (c & 127); } }
    float wv[32];
#pragma unroll
    for (int i = 0; i < 32; ++i) wv[i] = __builtin_nontemporal_load(W + (size_t)(k0 + 2 * i + (lane >> 5)) * N + n0 + (lane & 31));
    if (gk) {
#pragma unroll
        for (int i = 0; i < 32; ++i) wv[i] *= gk[k0 + 2 * i + (lane >> 5)];
    }
#pragma unroll
    for (int i = 0; i < 32; ++i) scr[(2 * i + (lane >> 5)) * 33 + (lane & 31)] = wv[i];
    asm volatile("s_waitcnt lgkmcnt(0)" ::: "memory");
    const int c = lane & 7;
#pragma unroll
    for (int j = 0; j < 4; ++j) { const int n = (lane >> 3) + 8 * j; const LAS float* s = scr + (8 * c) * 33 + n;
        u32x4 o; o.x = cvt_pk_bf16(s[0 * 33], s[1 * 33]); o.y = cvt_pk_bf16(s[2 * 33], s[3 * 33]); o.z = cvt_pk_bf16(s[4 * 33], s[5 * 33]); o.w = cvt_pk_bf16(s[6 * 33], s[7 * 33]);
        *(u32x4*)(WT + (size_t)(nd0 + n) * K + k0 + 8 * c) = o; }
    asm volatile("s_waitcnt lgkmcnt(0)" ::: "memory");
}
__device__ __forceinline__ void p0_prologue(const Params& p, LAS unsigned char* lds, int G) {
    int tid_ = threadIdx.x; asm volatile("" : "+v"(tid_)); const int tid = tid_, lane = tid & 63, wave = tid >> 6;
    LAS float* scr = (LAS float*)(lds + wave * 16384);
    const int gw = blockIdx.x * 8 + wave, NGW = G * 8;
    bf16_t* W1T = (bf16_t*)(p.ws + WS_W1T); bf16_t* W2T = (bf16_t*)(p.ws + WS_W2T); bf16_t* W3T = (bf16_t*)(p.ws + WS_W3T); bf16_t* W4T = (bf16_t*)(p.ws + WS_W4T);
    constexpr int I1 = (DM / 64) * (N1 / 32), I2 = (GW / 64) * (DM / 32), I3 = (DM / 64) * (N3 / 32), I4 = (DM / 64) * (DM / 32);
    bf16_t* h0 = (bf16_t*)(p.ws + WS_RA);
    for (int m = gw; m < MT; m += NGW) {
        const float* xrow = (m < MP) ? p.xp + (size_t)m * DM : p.xs + (size_t)(m - MP) * DM;
        f32x4 v[8]; float s = 0.f;
#pragma unroll
        for (int j = 0; j < 8; ++j) { v[j] = __builtin_nontemporal_load((const f32x4*)(xrow + 4 * lane + 256 * j)); s += (v[j][0] * v[j][0] + v[j][1] * v[j][1]) + (v[j][2] * v[j][2] + v[j][3] * v[j][3]); }
        const float rinv = __builtin_amdgcn_rsqf(wave_sum(s) * (1.0f / DM) + 1e-6f);
#pragma unroll
        for (int j = 0; j < 8; ++j) { const f32x4 gg = *(const f32x4*)(p.norm_g + 4 * lane + 256 * j);
            u32x2 w; w.x = cvt_pk_bf16(v[j][0] * rinv * gg[0], v[j][1] * rinv * gg[1]); w.y = cvt_pk_bf16(v[j][2] * rinv * gg[2], v[j][3] * rinv * gg[3]);
            *(u32x2*)(h0 + (size_t)m * DM + 4 * lane + 256 * j) = w; }
    }
    for (int it = gw; it < I1 + I2 + I3 + I4; it += NGW) {
        int r = it;
        if (r < I1) { p0_transpose_item(p.w1, DM, N1, W1T, nullptr, scr, r, lane, true); continue; } r -= I1;
        if (r < I2) { p0_transpose_item(p.w2, GW, DM, W2T, nullptr, scr, r, lane, false); continue; } r -= I2;
        if (r < I3) { p0_transpose_item(p.w3, DM, N3, W3T, p.norm_g + DM, scr, r, lane, false); continue; } r -= I3;
        p0_transpose_item(p.w4, DM, DM, W4T, nullptr, scr, r, lane, false);
    }
}

constexpr int MIX_WP = 136, MIX_VP = 264;
constexpr int MIX_W_OFF = 0, MIX_V_OFF = 128 * MIX_WP * 2, MIX_ST_OFF = MIX_V_OFF + 128 * MIX_VP * 2;
__device__ __forceinline__ void mix_phase(const Params& p, LAS unsigned char* lds, int G, bool dry) {
    int tid_ = threadIdx.x; asm volatile("" : "+v"(tid_)); const int tid = tid_, wid = tid >> 6, lane = tid & 63, wr = wid >> 2, wc = wid & 3, fr = lane & 15, fq = lane >> 4;
    bf16_t* gu = (bf16_t*)(p.ws + WS_RB); const bf16_t* gv = gu + SZ_G;
    const f32x2* lnp = (const f32x2*)(p.ws + WS_LNP);
    LAS bf16_t* Wl = (LAS bf16_t*)(lds + MIX_W_OFF); LAS bf16_t* Vl = (LAS bf16_t*)(lds + MIX_V_OFF); LAS float* st = (LAS float*)(lds + MIX_ST_OFF);
    unsigned* ctr = (unsigned*)(p.ws + WS_CTL) + 2; unsigned* pcnt = (unsigned*)(p.ws + WS_CTL) + 11264;
    volatile LAS int* misc = (volatile LAS int*)(lds + MIX_ST_OFF + 1024);
    unsigned long long seen = 0ull;
    if (tid == 0) misc[0] = (int)atomicAdd(ctr, 1u);
    for (;;) {
        __syncthreads();
        const int unit = misc[0];
        if (unit >= 66 * 16) break;
        const int nb = unit >> 4, g = unit & 15, row_base = nb * 128; const bool smp = nb >= 64;
        if (!((seen >> (nb >> 1)) & 1ull)) {
            if (tid < 64) pg8::panel_wait_wave0(pcnt, nb >> 1, 48u);
            seen |= 1ull << (nb >> 1);
        }
        __syncthreads();
        int nticket = 0;
        if (tid == 0) nticket = (int)atomicAdd(ctr, 1u);
        u32x4 raw[8];
#pragma unroll
        for (int i = 0; i < 8; ++i) { const int cid = tid + 512 * i, s = cid >> 5, c = (cid & 31) * 8; raw[i] = *(const u32x4*)(gv + (size_t)(row_base + s) * GW + g * 256 + c); }
        const int t = tid >> 2, s0 = (tid & 3) * 32; bool on; const float* src;
        if (smp) { on = (t >> 5) == (tid & 3); src = p.wsp + ((size_t)g * 128 + (t & 31)) * 128; }
        else { on = (s0 >> 6) <= (t >> 6); src = p.wsp + ((size_t)g * 128 + t) * 128 + s0; }
        f32x4 wa[8];
#pragma unroll
        for (int j = 0; j < 8; ++j) wa[j] = on ? *(const f32x4*)(src + 4 * j) : (f32x4){0.f, 0.f, 0.f, 0.f};
        float ssum = 0.f, qsum = 0.f;
        {   const f32x4* pp = (const f32x4*)(lnp + (size_t)(row_base + t) * 16) + (tid & 3) * 2;
#pragma unroll
            for (int i = 0; i < 2; ++i) { const f32x4 a = pp[i]; ssum += a[0] + a[2]; qsum += a[1] + a[3]; } }
        const int cc = g * 256 + (tid & 31) * 8;
        const f32x4 g0 = *(const f32x4*)(p.lng + cc), g1 = *(const f32x4*)(p.lng + cc + 4), b0 = *(const f32x4*)(p.lnb + cc), b1 = *(const f32x4*)(p.lnb + cc + 4);
        ssum += __shfl_xor(ssum, 1); qsum += __shfl_xor(qsum, 1); ssum += __shfl_xor(ssum, 2); qsum += __shfl_xor(qsum, 2);
        if ((tid & 3) == 0) { const float mean = ssum * (1.0f / GW), var = qsum * (1.0f / GW) - mean * mean; st[t] = mean; st[128 + t] = __builtin_amdgcn_rsqf(var + 1e-5f); }
#pragma unroll
        for (int j = 0; j < 4; ++j) { const f32x4 a = wa[2 * j], b2 = wa[2 * j + 1];
            u32x4 w; w.x = cvt_pk_bf16(a[0], a[1]); w.y = cvt_pk_bf16(a[2], a[3]); w.z = cvt_pk_bf16(b2[0], b2[1]); w.w = cvt_pk_bf16(b2[2], b2[3]);
            *(LAS u32x4*)(Wl + t * MIX_WP + s0 + 8 * j) = w; }
        __syncthreads();
#pragma unroll
        for (int i = 0; i < 8; ++i) {
            const int cid = tid + 512 * i, s = cid >> 5, c = (cid & 31) * 8;
            const float mu = st[s], rs = st[128 + s];
            f32x4 x0 = (f32x4){bf_lo(raw[i].x), bf_hi(raw[i].x), bf_lo(raw[i].y), bf_hi(raw[i].y)}, x1 = (f32x4){bf_lo(raw[i].z), bf_hi(raw[i].z), bf_lo(raw[i].w), bf_hi(raw[i].w)};
            x0 = (x0 - mu) * rs * g0 + b0; x1 = (x1 - mu) * rs * g1 + b1;
            if (smp) { float* o = p.out + O_GMV + (size_t)(row_base - MP + s) * GW + g * 256 + c; __builtin_nontemporal_store(x0, (f32x4*)o); __builtin_nontemporal_store(x1, (f32x4*)(o + 4)); }
            u32x4 w; w.x = cvt_pk_bf16(x0[0], x0[1]); w.y = cvt_pk_bf16(x0[2], x0[3]); w.z = cvt_pk_bf16(x1[0], x1[1]); w.w = cvt_pk_bf16(x1[2], x1[3]);
            *(LAS u32x4*)(Vl + s * MIX_VP + c) = w;
        }
        u32x2 ur[4][4]; float bias[4];
        bf16_t* const gup = gu + (size_t)(row_base + 64 * wr + fr) * GW + g * 256 + 64 * wc + 4 * fq;
#pragma unroll
        for (int m = 0; m < 4; ++m) {
            const int tt = 64 * wr + 16 * m + fr; bias[m] = p.bsp[g * 128 + (smp ? (tt & 31) : tt)];
#pragma unroll
            for (int n = 0; n < 4; ++n) ur[m][n] = *(const u32x2*)(gup + (size_t)m * 16 * GW + 16 * n);
        }
        __syncthreads();
        f32x4 acc[4][4];
#pragma unroll
        for (int m = 0; m < 4; ++m)
#pragma unroll
            for (int n = 0; n < 4; ++n) acc[m][n] = (f32x4){0.f, 0.f, 0.f, 0.f};
#pragma unroll
        for (int ks = 0; ks < 4; ++ks) {
            bf16x8 af[4], bfr[4];
#pragma unroll
            for (int m = 0; m < 4; ++m) af[m] = *(const LAS bf16x8*)(Wl + (64 * wr + 16 * m + fr) * MIX_WP + 32 * ks + 8 * fq);
#pragma unroll
            for (int n = 0; n < 4; ++n) {
                const LAS bf16_t* a0 = Vl + (32 * ks + 8 * fq + (fr >> 2)) * MIX_VP + 64 * wc + 16 * n + 4 * (fr & 3);
                const s16x4 lo = __builtin_amdgcn_ds_read_tr16_b64_v4i16((LAS s16x4*)a0), hi = __builtin_amdgcn_ds_read_tr16_b64_v4i16((LAS s16x4*)(a0 + 4 * MIX_VP));
                bfr[n] = (bf16x8){lo[0], lo[1], lo[2], lo[3], hi[0], hi[1], hi[2], hi[3]};
            }
#pragma unroll
            for (int m = 0; m < 4; ++m)
#pragma unroll
                for (int n = 0; n < 4; ++n) acc[m][n] = __builtin_amdgcn_mfma_f32_16x16x32_bf16(bfr[n], af[m], acc[m][n], 0, 0, 0);
        }
#pragma unroll
        for (int m = 0; m < 4; ++m) {
#pragma unroll
            for (int n = 0; n < 4; ++n) {
                const f32x4 a = acc[m][n] + bias[m]; const u32x2 u2 = ur[m][n];
                u32x2 w; w.x = cvt_pk_bf16(bf_lo(u2.x) * a[0], bf_hi(u2.x) * a[1]); w.y = cvt_pk_bf16(bf_lo(u2.y) * a[2], bf_hi(u2.y) * a[3]);
                if (!dry) *(u32x2*)(gup + (size_t)m * 16 * GW + 16 * n) = w;
            }
        }
        if (tid == 0) misc[0] = nticket;
    }
}

constexpr int AT_P = 136;
constexpr int AT_K_OFF = 0, AT_V_OFF = 64 * AT_P * 2, AT_MISC_OFF = 2 * 64 * AT_P * 2;
constexpr int AT_ITEMS = 512 + 128;
__device__ __forceinline__ void attn_phase(const Params& p, LAS unsigned char* lds, int cidx) {
    int tid_ = threadIdx.x; asm volatile("" : "+v"(tid_)); const int tid = tid_, wid = __builtin_amdgcn_readfirstlane(tid >> 6), lane = tid & 63, fr = lane & 15, fq = lane >> 4;
    const bf16_t* qb = (const bf16_t*)(p.ws + WS_RB) + 2 * SZ_D; const bf16_t* kb = qb + SZ_D; const bf16_t* vb = qb + 2 * SZ_D; const bf16_t* sz1 = qb + 3 * SZ_D; bf16_t* y1 = (bf16_t*)(p.ws + WS_W1T);
    unsigned* ctr = (unsigned*)(p.ws + WS_CTL) + cidx; unsigned* pcnt = (unsigned*)(p.ws + WS_CTL) + 8192; unsigned* g3cnt = (unsigned*)(p.ws + WS_CTL) + 20480;
    unsigned long long pseen = 0ull;
#define AT_ENSURE(pm_) do { const int _pm = (pm_); if (!((pseen >> _pm) & 1ull)) { if (tid < 64) pg8::panel_wait_wave0(g3cnt, _pm, 32u); __syncthreads(); pseen |= 1ull << _pm; } } while (0)
    LAS bf16_t* Kl = (LAS bf16_t*)(lds + AT_K_OFF); LAS bf16_t* Vl = (LAS bf16_t*)(lds + AT_V_OFF); volatile LAS int* misc = (volatile LAS int*)(lds + AT_MISC_OFF);
    int prev_pm = -1, cur_pm = -1;
    for (;;) {
        __syncthreads();
        if (tid == 0) misc[0] = (int)atomicAdd(ctr, 1u);
        __syncthreads();
        const int item = misc[0];
        if (item >= AT_ITEMS) break;
        prev_pm = cur_pm;
        const bool smp = item < 128;
        int b, h, x, kt_hi, qrow0, tpos0; size_t krow0;
        if (!smp) { const int it = item - 128; x = it >> 6; const int bh = it & 63; b = bh >> 4; h = bh & 15; kt_hi = 4 * x + 3; qrow0 = b * 2048 + x * 256 + 32 * wid; tpos0 = x * 256 + 32 * wid; krow0 = (size_t)b * 2048; cur_pm = b * 8 + x; }
        else { x = 0; const int bh = item; b = bh >> 4; h = bh & 15; kt_hi = 16; qrow0 = MP + b * 32; tpos0 = 1024; krow0 = 0; cur_pm = 32; }
        const bool active = !smp || wid == 0;
        AT_ENSURE(cur_pm);
        bf16x8 qf[2][4];
#pragma unroll
        for (int mt = 0; mt < 2; ++mt)
#pragma unroll
            for (int kk = 0; kk < 4; ++kk) qf[mt][kk] = *(const bf16x8*)(qb + (size_t)(qrow0 + 16 * mt + fr) * DM + h * 128 + 32 * kk + 8 * fq);
        f32x4 o[2][8];
#pragma unroll
        for (int mt = 0; mt < 2; ++mt)
#pragma unroll
            for (int dt = 0; dt < 8; ++dt) o[mt][dt] = (f32x4){0.f, 0.f, 0.f, 0.f};
        float C[2] = {0.f, 0.f};
        bool wdone = !active;
        if (lane == 0) misc[8 + wid] = wdone ? 1 : 0;
        f32x4 pf[2][4];
        if (!smp) {
#pragma unroll
            for (int i = 0; i < 2; ++i) { const int cid = tid + 512 * i, key = cid >> 4, d8 = (cid & 15) * 8; const size_t off = (krow0 + kt_hi * 64 + key) * DM + h * 128 + d8;
                pf[i][0] = __builtin_bit_cast(f32x4, *(const u32x4*)(kb + off)); pf[i][2] = __builtin_bit_cast(f32x4, *(const u32x4*)(vb + off)); }
        }
        for (int kt = kt_hi; kt >= 0; --kt) {
            __syncthreads();
            {
                int alld = 1;
#pragma unroll
                for (int w = 0; w < 8; ++w) alld &= misc[8 + w];
                if (alld) break;
            }
#pragma unroll
            for (int i = 0; i < 2; ++i) {
                const int cid = tid + 512 * i, key = cid >> 4, d8 = (cid & 15) * 8;
                u32x4 kwv, vwv;
                if (!smp) { kwv = __builtin_bit_cast(u32x4, pf[i][0]); vwv = __builtin_bit_cast(u32x4, pf[i][2]); }
                else if (kt == 16) {
                    if (key < 32) { const size_t off = (size_t)(MP + b * 32 + key) * DM + h * 128 + d8; kwv = *(const u32x4*)(kb + off); vwv = *(const u32x4*)(vb + off); }
                    else { kwv = (u32x4){0u, 0u, 0u, 0u}; vwv = kwv; }
                } else {
                    const f32x4 k0 = pf[i][0], k1 = pf[i][1], v0 = pf[i][2], v1 = pf[i][3];
                    kwv.x = cvt_pk_bf16(k0[0], k0[1]); kwv.y = cvt_pk_bf16(k0[2], k0[3]); kwv.z = cvt_pk_bf16(k1[0], k1[1]); kwv.w = cvt_pk_bf16(k1[2], k1[3]);
                    vwv.x = cvt_pk_bf16(v0[0], v0[1]); vwv.y = cvt_pk_bf16(v0[2], v0[3]); vwv.z = cvt_pk_bf16(v1[0], v1[1]); vwv.w = cvt_pk_bf16(v1[2], v1[3]);
                }
                *(LAS u32x4*)(Kl + key * AT_P + d8) = kwv; *(LAS u32x4*)(Vl + key * AT_P + d8) = vwv;
            }
            if (kt > 0 && !smp) AT_ENSURE(b * 8 + ((kt - 1) >> 2));
            if (kt > 0) {
#pragma unroll
                for (int i = 0; i < 2; ++i) {
                    const int cid = tid + 512 * i, key = cid >> 4, d8 = (cid & 15) * 8;
                    if (!smp) { const size_t off = (krow0 + (kt - 1) * 64 + key) * DM + h * 128 + d8; pf[i][0] = __builtin_bit_cast(f32x4, *(const u32x4*)(kb + off)); pf[i][2] = __builtin_bit_cast(f32x4, *(const u32x4*)(vb + off)); }
                    else { const size_t off = (((size_t)b * 1024 + (kt - 1) * 64 + key) * 16 + h) * 128 + d8;
                        pf[i][0] = *(const f32x4*)(p.ck + off); pf[i][1] = *(const f32x4*)(p.ck + off + 4); pf[i][2] = *(const f32x4*)(p.cv + off); pf[i][3] = *(const f32x4*)(p.cv + off + 4); }
                }
            }
            __syncthreads();
            if (!wdone && kt * 64 < tpos0 + 31) {
                f32x4 st[2][4];
#pragma unroll
                for (int mt = 0; mt < 2; ++mt)
#pragma unroll
                    for (int n = 0; n < 4; ++n) st[mt][n] = (f32x4){0.f, 0.f, 0.f, 0.f};
#pragma unroll
                for (int kk = 0; kk < 4; ++kk)
#pragma unroll
                    for (int n = 0; n < 4; ++n) {
                        const bf16x8 kf = *(const LAS bf16x8*)(Kl + (16 * (fr >> 2) + 4 * n + (fr & 3)) * AT_P + 32 * kk + 8 * fq);
                        st[0][n] = __builtin_amdgcn_mfma_f32_16x16x32_bf16(kf, qf[0][kk], st[0][n], 0, 0, 0);
                        st[1][n] = __builtin_amdgcn_mfma_f32_16x16x32_bf16(kf, qf[1][kk], st[1][n], 0, 0, 0);
                    }
                bf16x8 pb[2][2];
                {
                    const int s0 = kt * 64 + 16 * fq, tq0 = tpos0 + fr, tq1 = tpos0 + 16 + fr;
                    f32x2 run = (f32x2){0.f, 0.f};
#pragma unroll
                    for (int idx = 15; idx >= 0; --idx) {
                        const f32x2 xv = (f32x2){st[0][idx >> 2][idx & 3], st[1][idx >> 2][idx & 3]};
                        const f32x2 ax = __builtin_elementwise_abs(xv);
                        f32x2 e; e.x = __builtin_amdgcn_exp2f(-ax.x); e.y = __builtin_amdgcn_exp2f(-ax.y);
                        const f32x2 e1 = e + 1.0f;
                        f32x2 lg; lg.x = __builtin_amdgcn_logf(e1.x); lg.y = __builtin_amdgcn_logf(e1.y);
                        const f32x2 sp = __builtin_elementwise_max(xv, (f32x2){0.f, 0.f}) + lg;
                        const f32x2 lw = (xv - sp) + run;
                        st[0][idx >> 2][idx & 3] = lw.x; st[1][idx >> 2][idx & 3] = lw.y;
                        f32x2 dec; dec.x = (s0 + idx) < tq0 ? sp.x : 0.f; dec.y = (s0 + idx) < tq1 ? sp.y : 0.f;
                        run = run - dec;
                    }
                    f32x2 t16, t32, t48;
                    t16.x = __shfl(run.x, (lane + 16) & 63); t16.y = __shfl(run.y, (lane + 16) & 63);
                    t32.x = __shfl(run.x, (lane + 32) & 63); t32.y = __shfl(run.y, (lane + 32) & 63);
                    t48.x = __shfl(run.x, (lane + 48) & 63); t48.y = __shfl(run.y, (lane + 48) & 63);
                    const f32x2 z2 = (f32x2){0.f, 0.f};
                    const f32x2 higher = (fq < 3 ? t16 : z2) + (fq < 2 ? t32 : z2) + (fq < 1 ? t48 : z2);
                    const f32x2 base = (f32x2){C[0], C[1]} + higher;
                    const f32x2 tot = (run + t16) + (t32 + t48);
                    C[0] += tot.x; C[1] += tot.y;
                    float w0[16], w1[16];
#pragma unroll
                    for (int idx = 0; idx < 16; ++idx) {
                        const f32x2 a2 = (f32x2){st[0][idx >> 2][idx & 3], st[1][idx >> 2][idx & 3]} + base;
                        w0[idx] = (s0 + idx) < tq0 ? __builtin_amdgcn_exp2f(a2.x) : 0.f;
                        w1[idx] = (s0 + idx) < tq1 ? __builtin_amdgcn_exp2f(a2.y) : 0.f;
                    }
#pragma unroll
                    for (int k2 = 0; k2 < 2; ++k2) {
                        u32x4 pw; pw.x = cvt_pk_bf16(w0[8 * k2 + 0], w0[8 * k2 + 1]); pw.y = cvt_pk_bf16(w0[8 * k2 + 2], w0[8 * k2 + 3]); pw.z = cvt_pk_bf16(w0[8 * k2 + 4], w0[8 * k2 + 5]); pw.w = cvt_pk_bf16(w0[8 * k2 + 6], w0[8 * k2 + 7]);
                        pb[0][k2] = __builtin_bit_cast(bf16x8, pw);
                        u32x4 pv; pv.x = cvt_pk_bf16(w1[8 * k2 + 0], w1[8 * k2 + 1]); pv.y = cvt_pk_bf16(w1[8 * k2 + 2], w1[8 * k2 + 3]); pv.z = cvt_pk_bf16(w1[8 * k2 + 4], w1[8 * k2 + 5]); pv.w = cvt_pk_bf16(w1[8 * k2 + 6], w1[8 * k2 + 7]);
                        pb[1][k2] = __builtin_bit_cast(bf16x8, pv);
                    }
                }
#pragma unroll
                for (int k2 = 0; k2 < 2; ++k2)
#pragma unroll
                    for (int dt = 0; dt < 8; ++dt) {
                        const LAS bf16_t* a0 = Vl + (16 * fq + 8 * k2 + (fr >> 2)) * AT_P + 16 * dt + 4 * (fr & 3);
                        const s16x4 lo = __builtin_amdgcn_ds_read_tr16_b64_v4i16((LAS s16x4*)a0), hi = __builtin_amdgcn_ds_read_tr16_b64_v4i16((LAS s16x4*)(a0 + 4 * AT_P));
                        const bf16x8 vf = (bf16x8){lo[0], lo[1], lo[2], lo[3], hi[0], hi[1], hi[2], hi[3]};
                        o[0][dt] = __builtin_amdgcn_mfma_f32_16x16x32_bf16(vf, pb[0][k2], o[0][dt], 0, 0, 0);
                        o[1][dt] = __builtin_amdgcn_mfma_f32_16x16x32_bf16(vf, pb[1][k2], o[1][dt], 0, 0, 0);
                    }
                if (__builtin_amdgcn_ballot_w64(C[0] < -160.f && C[1] < -160.f) == ~0ull) { wdone = true;     if (lane == 0) misc[8 + wid] = 1; }
            }
        }
        asm volatile("s_waitcnt vmcnt(0)" ::: "memory");
        __syncthreads();
        if (tid == 0 && prev_pm >= 0) __hip_atomic_fetch_add(pcnt + 64 * prev_pm, 1u, __ATOMIC_RELAXED, __HIP_MEMORY_SCOPE_AGENT);
        if (active) {
#pragma unroll
            for (int mt = 0; mt < 2; ++mt)
#pragma unroll
                for (int dt = 0; dt < 8; ++dt) {
                    const size_t off = (size_t)(qrow0 + 16 * mt + fr) * DM + h * 128 + 16 * dt + 4 * fq;
                    const u32x2 zr = *(const u32x2*)(sz1 + off); const f32x4 a = o[mt][dt];
                    u32x2 w; w.x = cvt_pk_bf16(a[0] * bf_lo(zr.x), a[1] * bf_hi(zr.x)); w.y = cvt_pk_bf16(a[2] * bf_lo(zr.y), a[3] * bf_hi(zr.y));
                    st_wt8(y1 + off, w);
                }
        }
        if (smp) {
            asm volatile("s_waitcnt vmcnt(0)" ::: "memory");
            __syncthreads();
            if (tid == 0) __hip_atomic_fetch_add(pcnt + 64 * 32, 1u, __ATOMIC_RELAXED, __HIP_MEMORY_SCOPE_AGENT);
            cur_pm = -1;
        }
    }
    asm volatile("s_waitcnt vmcnt(0)" ::: "memory");
    __syncthreads();
    if (tid == 0 && cur_pm >= 0) __hip_atomic_fetch_add(pcnt + 64 * cur_pm, 1u, __ATOMIC_RELAXED, __HIP_MEMORY_SCOPE_AGENT);
}

#undef AT_ENSURE
__device__ __forceinline__ void final_phase(const Params& p, int G) {
    int tid_ = threadIdx.x; asm volatile("" : "+v"(tid_)); const int tid = tid_, lane = tid & 63, wave = tid >> 6;
    const float* ss2 = (const float*)(p.ws + WS_SS2);
    for (int m = blockIdx.x * 8 + wave; m < MT; m += G * 8) {
        const float s = wave_sum(lane < 32 ? ss2[(size_t)m * 32 + lane] : 0.f);
        const float rinv = __builtin_amdgcn_rsqf(s * (1.0f / DM) + 1e-6f);
        float* row = p.out + (size_t)m * DM;
#pragma unroll
        for (int j = 0; j < 8; ++j) { const f32x4 v = *(const f32x4*)(row + 4 * lane + 256 * j), gg = *(const f32x4*)(p.fng + 4 * lane + 256 * j); *(f32x4*)(row + 4 * lane + 256 * j) = v * rinv * gg; }
    }
}


#define XB_TMO      128
#define XB_XCNT(j)  (256  + 64 * (j))
#define XB_XSUB(j)  (1280 + 64 * (j))
#define XB_XGEN(j)  (2304 + 64 * (j))
#define XB_TOP      3328
#define XB_TOPGEN   3392
#define XCD_BAR_WORDS 3456
#define XB_SPIN_CAP (1u << 20)
__device__ __forceinline__ unsigned xb_ld(unsigned* p)              { return __hip_atomic_load(p, __ATOMIC_RELAXED, __HIP_MEMORY_SCOPE_AGENT); }
__device__ __forceinline__ unsigned xb_add(unsigned* p, unsigned v) { return __hip_atomic_fetch_add(p, v, __ATOMIC_RELAXED, __HIP_MEMORY_SCOPE_AGENT); }
__device__ __forceinline__ unsigned xb_xcc_id() { return (unsigned)__builtin_amdgcn_s_getreg((3 << 11) | 20) & 0xFu; }
#define XB_SPIN(cond, bar) do { unsigned _sp = 0; while (cond) { __builtin_amdgcn_s_sleep(1); \
    if ((++_sp & 255u) == 0u) { if (xb_ld(&(bar)[XB_TMO])) break; if (_sp > XB_SPIN_CAP) { atomicAdd(&(bar)[XB_TMO], 1u); break; } } } } while (0)
struct XcdBarrier { unsigned* bar; unsigned x; volatile LAS unsigned* st; };
__device__ __forceinline__ XcdBarrier xcd_barrier_post(unsigned* bar, volatile LAS unsigned* st) {
    XcdBarrier b; b.bar = bar; b.x = xb_xcc_id(); b.st = st;
    if (threadIdx.x == 0) (void)xb_add(&bar[XB_XCNT(b.x)], 1u);
    return b;
}
__device__ __forceinline__ void xcd_barrier_complete(unsigned* bar, unsigned x, unsigned& nloc, unsigned& nx) {
    const unsigned G = gridDim.x * gridDim.y * gridDim.z;
    unsigned sum, cnt, mine, sp = 0u;
    for (;;) {
        sum = 0u; cnt = 0u; mine = 0u;
#pragma unroll
        for (unsigned j = 0; j < 16; ++j) { const unsigned c = xb_ld(&bar[XB_XCNT(j)]); sum += c; cnt += (c > 0u) ? 1u : 0u; mine = (j == x) ? c : mine; }
        if (sum == G) break;
        __builtin_amdgcn_s_sleep(1);
        if ((++sp & 255u) == 0u) { if (xb_ld(&bar[XB_TMO])) break; if (sp > XB_SPIN_CAP) { atomicAdd(&bar[XB_TMO], 1u); break; } }
    }
    nloc = mine > 0u ? mine : 1u; nx = cnt > 0u ? cnt : 1u;
}
__device__ __forceinline__ void xcd_barrier(const XcdBarrier& b) {
    asm volatile("s_waitcnt vmcnt(0)" ::: "memory");
    __syncthreads();
    if (threadIdx.x == 0) {
        unsigned* bar = b.bar;
        __builtin_amdgcn_s_waitcnt(0);
        unsigned nloc = b.st[0], nx = b.st[1];
        if (nloc == 0u) { xcd_barrier_complete(bar, b.x, nloc, nx); b.st[0] = nloc; b.st[1] = nx; }
        const unsigned old = xb_add(&bar[XB_XSUB(b.x)], 1u);
        const unsigned gen = old / nloc;
        if (old + 1u == (gen + 1u) * nloc) {
            __builtin_amdgcn_fence(__ATOMIC_RELEASE, "agent");
            asm volatile("s_waitcnt vmcnt(0)" ::: "memory");
            const unsigned og = xb_add(&bar[XB_TOP], 1u);
            const unsigned tg = og / nx;
            if (og + 1u == (tg + 1u) * nx) xb_add(&bar[XB_TOPGEN], 1u);
            else XB_SPIN(xb_ld(&bar[XB_TOPGEN]) == tg, bar);
            __builtin_amdgcn_fence(__ATOMIC_ACQUIRE, "agent");
            xb_add(&bar[XB_XGEN(b.x)], 1u);
            asm volatile("s_waitcnt vmcnt(0)" ::: "memory");
        } else {
            XB_SPIN(xb_ld(&bar[XB_XGEN(b.x)]) == gen, bar);
            __builtin_amdgcn_fence(__ATOMIC_ACQUIRE, "agent");
            asm volatile("s_waitcnt vmcnt(0)" ::: "memory");
        }
    }
    __syncthreads();
}

#ifndef DUP
#define DUP 0
#endif
constexpr int LDS_BYTES = 131072 + 4096 + 8192;
__global__ void __launch_bounds__(512, 2) fwd_megakernel(Params p) {
    extern __shared__ __attribute__((aligned(16))) unsigned char lds_raw[];
    LAS unsigned char* lds = (LAS unsigned char*)lds_raw;
    cg::grid_group grid = cg::this_grid();
    const int G = gridDim.x;
    bf16_t* RA = (bf16_t*)(p.ws + WS_RA); bf16_t* RB = (bf16_t*)(p.ws + WS_RB);
    volatile LAS unsigned* xst = (volatile LAS unsigned*)(lds + 131072 + 2048);
    if (threadIdx.x < 4) xst[threadIdx.x] = 0u;
    __syncthreads();
    const XcdBarrier xbar = xcd_barrier_post((unsigned*)(p.ws + WS_CTL) + 1024, xst);
    p0_prologue(p, lds, G);
    if (DUP == 1) { __syncthreads(); p0_prologue(p, lds, G); }
    if (p.ws == nullptr) grid.sync();
    xcd_barrier(xbar);
    {
        pg8::Gemm g{RA, (const bf16_t*)(p.ws + WS_W1T), MT, N1, DM}; pg8::OrderG1 S; S.init(G, (int)blockIdx.x, (unsigned*)(p.ws + WS_CTL) + 11264);
        EpiG1 E{RB, (f32x2*)(p.ws + WS_LNP), (LAS f32x2*)(lds + 131072 + 4096)};
        pg8::gemm_phase<EpiG1, pg8::OrderG1>(lds, g, S, E);
    }
    mix_phase(p, lds, G, false);
    xcd_barrier(xbar);
    {
        unsigned* cnt = (unsigned*)(p.ws + WS_CTL) + 5120;
        {
            pg8::Gemm g{RB, (const bf16_t*)(p.ws + WS_W2T), MT, DM, GW}; pg8::OrderG2 S; S.init(G, (int)blockIdx.x, cnt);
            EpiRes<true> E{p.xp, p.xs, p.out, RA, (float*)(p.ws + WS_SS1)};
            pg8::gemm_phase<EpiRes<true>, pg8::OrderG2>(lds, g, S, E);
        }
        {
            pg8::Gemm g{RA, (const bf16_t*)(p.ws + WS_W3T), MT, N3, DM}; pg8::OrderG3 S; S.init(G, (int)blockIdx.x, cnt, (unsigned*)(p.ws + WS_CTL) + 20480);
            EpiG3 E{RB + 2 * SZ_D, (const float*)(p.ws + WS_SS1), p.out};
            pg8::gemm_phase<EpiG3, pg8::OrderG3>(lds, g, S, E);
        }
    }
    if (!(G == 256 && blockIdx.x < 8)) attn_phase(p, lds, 0);
    if (G == 256) {
        pg8::Gemm g{(const bf16_t*)(p.ws + WS_W1T), (const bf16_t*)(p.ws + WS_W4T), MT, DM, DM}; pg8::OrderG4 S; S.init(G, (int)blockIdx.x, (unsigned*)(p.ws + WS_CTL) + 8192);
        EpiFinal E{p.out, (float*)(p.ws + WS_SS2), p.fng, (unsigned*)(p.ws + WS_CTL) + 14336};
        pg8::gemm_phase<EpiFinal, pg8::OrderG4>(lds, g, S, E);
        return;
    }
    {
        pg8::Gemm g{(const bf16_t*)(p.ws + WS_W1T), (const bf16_t*)(p.ws + WS_W4T), MT, DM, DM}; pg8::OrderG4 S; S.init(G, (int)blockIdx.x, (unsigned*)(p.ws + WS_CTL) + 8192);
        EpiRes<false> E{nullptr, nullptr, p.out, nullptr, (float*)(p.ws + WS_SS2)};
        pg8::gemm_phase<EpiRes<false>, pg8::OrderG4>(lds, g, S, E);
    }
    xcd_barrier(xbar);
    final_phase(p, G);
}

extern "C" void kernel_launch(void* const* d_in, const int* in_sizes, int n_in, void* d_out, int out_size, void* d_ws, size_t ws_size, hipStream_t stream) {
    static int grid_blocks = 0;
    if (!grid_blocks) {
        int dev = 0, cus = 0, per_cu = 0;
        (void)hipGetDevice(&dev);
        (void)hipDeviceGetAttribute(&cus, hipDeviceAttributeMultiprocessorCount, dev);
        (void)hipFuncSetAttribute((const void*)fwd_megakernel, hipFuncAttributeMaxDynamicSharedMemorySize, LDS_BYTES);
        (void)hipOccupancyMaxActiveBlocksPerMultiprocessor(&per_cu, (const void*)fwd_megakernel, 512, LDS_BYTES);
        if (per_cu < 1) per_cu = 1;
        grid_blocks = cus * per_cu;
        if (ws_size < 348 * MiB) fprintf(stderr, "kernel_launch: workspace too small: %zu\n", ws_size);
    }
    (void)hipMemsetAsync((char*)d_ws + WS_CTL, 0, 131072, stream);
    Params p{};
    p.xp = (const float*)d_in[0]; p.xs = (const float*)d_in[1]; p.ck = (const float*)d_in[2]; p.cv = (const float*)d_in[3]; p.norm_g = (const float*)d_in[4]; p.fng = (const float*)d_in[5];
    p.w1 = (const float*)d_in[6]; p.lng = (const float*)d_in[7]; p.lnb = (const float*)d_in[8]; p.wsp = (const float*)d_in[9]; p.bsp = (const float*)d_in[10]; p.w2 = (const float*)d_in[11];
    p.w3 = (const float*)d_in[12]; p.w4 = (const float*)d_in[13]; p.out = (float*)d_out; p.ws = (unsigned char*)d_ws;
    void* args[] = {&p};
    hipError_t e = hipLaunchCooperativeKernel((void*)fwd_megakernel, dim3(grid_blocks), dim3(512), args, LDS_BYTES, stream);
    if (e != hipSuccess) fprintf(stderr, "cooperative launch failed: %s (grid %d)\n", hipGetErrorString(e), grid_blocks);
}
```
